# Optimizing an MI355X kernel written in HIP

```python
import math
import jax, jax.numpy as jnp
from jax import lax
import numpy as np

D_MODEL = 2048
BATCH = 4
SEQ = 2048
DEPTH = 1

CHUNK = 64
Q_BLOCK = 128
ROPE_THETA = 10000.0
NORM_EPS = 1e-6

MLA_HEADS = 8
MLA_Q_RANK = 512
MLA_KV_RANK = 512
MLA_NOPE_DIM = 128
MLA_ROPE_DIM = 64
MLA_V_DIM = 128
MLA_QK_DIM = MLA_NOPE_DIM + MLA_ROPE_DIM

DIFF_HEADS = 4
DIFF_HEAD_DIM = 128
DIFF_V_DIM = 2 * DIFF_HEAD_DIM

MLA_OUT = MLA_HEADS * MLA_V_DIM
DIFF_OUT = DIFF_HEADS * DIFF_V_DIM
MIX_WIDTH = MLA_OUT + DIFF_OUT

DIFF_QK_W = DIFF_HEADS * 2 * DIFF_HEAD_DIM
IN_WIDTHS = (MLA_Q_RANK, MLA_KV_RANK, MLA_ROPE_DIM, DIFF_QK_W, DIFF_QK_W, DIFF_OUT)
IN_SPLITS = tuple(int(v) for v in np.cumsum(IN_WIDTHS)[:-1])
IN_WIDTH = int(sum(IN_WIDTHS))

D_FF = 5632

kernel_name = "hybrid_mla_diffattn_macaron_block"


def rms_norm(x, g):
    xf = x.astype(jnp.float32)
    y = xf * lax.rsqrt(jnp.mean(xf * xf, axis=-1, keepdims=True) + NORM_EPS)
    return (y * g.astype(jnp.float32)).astype(x.dtype)


def rotate_half(x):
    x1, x2 = jnp.split(x, 2, axis=-1)
    return jnp.concatenate([-x2, x1], axis=-1)


def apply_rope(x):
    s, d = x.shape[1], x.shape[-1]
    pos = jnp.arange(s, dtype=jnp.float32)
    inv_freq = ROPE_THETA ** (-jnp.arange(0, d, 2, dtype=jnp.float32) / d)
    ang = pos[:, None] * inv_freq[None, :]
    ang = jnp.concatenate([ang, ang], axis=-1)
    bshape = (1, s) + (1,) * (x.ndim - 3) + (d,)
    cos = jnp.cos(ang).reshape(bshape).astype(x.dtype)
    sin = jnp.sin(ang).reshape(bshape).astype(x.dtype)
    return x * cos + rotate_half(x) * sin


def swiglu(x, w_gate, w_up, w_down):
    return (jax.nn.silu(x @ w_gate) * (x @ w_up)) @ w_down


def query_blocks(t):
    b, s = t.shape[0], t.shape[1]
    return jnp.moveaxis(t.reshape((b, s // Q_BLOCK, Q_BLOCK) + t.shape[2:]), 1, 0)


def merge_blocks(t):
    t = jnp.moveaxis(t, 0, 1)
    return t.reshape((t.shape[0], t.shape[1] * t.shape[2]) + t.shape[3:])


def chunk_mask(start, seq):
    q_pos = start + jnp.arange(Q_BLOCK, dtype=jnp.int32)
    k_pos = jnp.arange(seq, dtype=jnp.int32)
    return (q_pos[:, None] // CHUNK) >= (k_pos[None, :] // CHUNK)


def block_starts(seq):
    return jnp.arange(seq // Q_BLOCK, dtype=jnp.int32) * Q_BLOCK


def mla_attention(q, k, v):
    seq = q.shape[1]
    scale = MLA_QK_DIM ** -0.5

    def step(args):
        qb, start = args
        s = jnp.einsum('bqhd,bkhd->bhqk', qb, k, preferred_element_type=jnp.float32) * scale
        s = jnp.where(chunk_mask(start, seq)[None, None], s, -jnp.inf)
        p = jax.nn.softmax(s, axis=-1).astype(v.dtype)
        return jnp.einsum('bhqk,bkhd->bqhd', p, v)

    return merge_blocks(lax.map(step, (query_blocks(q), block_starts(seq))))


def diff_attention(q, k, v, lam):
    seq = q.shape[1]
    scale = DIFF_HEAD_DIM ** -0.5

    def step(args):
        qb, start = args
        s = jnp.einsum('bqhcd,bkhcd->bhcqk', qb, k, preferred_element_type=jnp.float32) * scale
        s = jnp.where(chunk_mask(start, seq)[None, None, None], s, -jnp.inf)
        p = jax.nn.softmax(s, axis=-1)
        a = (p[:, :, 0] - lam * p[:, :, 1]).astype(v.dtype)
        return jnp.einsum('bhqk,bkhe->bqhe', a, v)

    return merge_blocks(lax.map(step, (query_blocks(q), block_starts(seq))))


def setup_inputs(seed: int = 0) -> dict:
    key = jax.random.key(seed)
    ks = iter(jax.random.split(key, 32))

    def w(shape, fan_in):
        return jax.random.normal(next(ks), (DEPTH,) + shape, jnp.float32) * (fan_in ** -0.5)

    def gain(dim):
        return 1.0 + 0.02 * jax.random.normal(next(ks), (DEPTH, dim), jnp.float32)

    def lam_vec():
        return 0.1 * jax.random.normal(next(ks), (DEPTH, DIFF_HEAD_DIM), jnp.float32)

    x = jax.random.normal(next(ks), (BATCH, SEQ, D_MODEL), jnp.float32)
    return {
        "x": x,
        "ffn1_pre_g": gain(D_MODEL),
        "ffn1_w_gate": w((D_MODEL, D_FF), D_MODEL),
        "ffn1_w_up": w((D_MODEL, D_FF), D_MODEL),
        "ffn1_w_down": w((D_FF, D_MODEL), D_FF),
        "ffn1_post_g": gain(D_MODEL),
        "mix_pre_g": gain(D_MODEL),
        "w_in": w((D_MODEL, IN_WIDTH), D_MODEL),
        "mla_q_norm_g": gain(MLA_Q_RANK),
        "mla_w_uq": w((MLA_Q_RANK, MLA_HEADS * MLA_QK_DIM), MLA_Q_RANK),
        "mla_kv_norm_g": gain(MLA_KV_RANK),
        "mla_w_ukv": w((MLA_KV_RANK, MLA_HEADS * (MLA_NOPE_DIM + MLA_V_DIM)), MLA_KV_RANK),
        "diff_lambda_q1": lam_vec(),
        "diff_lambda_k1": lam_vec(),
        "diff_lambda_q2": lam_vec(),
        "diff_lambda_k2": lam_vec(),
        "diff_subln_g": gain(DIFF_V_DIM),
        "w_out": w((MIX_WIDTH, D_MODEL), MIX_WIDTH),
        "mix_post_g": gain(D_MODEL),
        "ffn2_pre_g": gain(D_MODEL),
        "ffn2_w_gate": w((D_MODEL, D_FF), D_MODEL),
        "ffn2_w_up": w((D_MODEL, D_FF), D_MODEL),
        "ffn2_w_down": w((D_FF, D_MODEL), D_FF),
        "ffn2_post_g": gain(D_MODEL),
    }


def reference(x, ffn1_pre_g, ffn1_w_gate, ffn1_w_up, ffn1_w_down, ffn1_post_g,
              mix_pre_g, w_in, mla_q_norm_g, mla_w_uq, mla_kv_norm_g, mla_w_ukv,
              diff_lambda_q1, diff_lambda_k1, diff_lambda_q2, diff_lambda_k2, diff_subln_g,
              w_out, mix_post_g, ffn2_pre_g, ffn2_w_gate, ffn2_w_up, ffn2_w_down, ffn2_post_g):
    b, s, _ = x.shape
    for l in range(DEPTH):
        f = swiglu(rms_norm(x, ffn1_pre_g[l]), ffn1_w_gate[l], ffn1_w_up[l], ffn1_w_down[l])
        x = x + 0.5 * rms_norm(f, ffn1_post_g[l])

        h = rms_norm(x, mix_pre_g[l])
        c_q, c_kv, k_rope, dq, dk, dv = jnp.split(h @ w_in[l], IN_SPLITS, axis=-1)

        q = (rms_norm(c_q, mla_q_norm_g[l]) @ mla_w_uq[l]).reshape(b, s, MLA_HEADS, MLA_QK_DIM)
        q_nope, q_pe = jnp.split(q, [MLA_NOPE_DIM], axis=-1)
        q = jnp.concatenate([q_nope, apply_rope(q_pe)], axis=-1)
        kv = (rms_norm(c_kv, mla_kv_norm_g[l]) @ mla_w_ukv[l]).reshape(b, s, MLA_HEADS, MLA_NOPE_DIM + MLA_V_DIM)
        k_nope, v = jnp.split(kv, [MLA_NOPE_DIM], axis=-1)
        k_pe = jnp.broadcast_to(apply_rope(k_rope)[:, :, None, :], (b, s, MLA_HEADS, MLA_ROPE_DIM))
        k = jnp.concatenate([k_nope, k_pe], axis=-1)
        o_mla = mla_attention(q, k, v).reshape(b, s, MLA_OUT)

        lambda_init = 0.8 - 0.6 * math.exp(-0.3 * l)
        lam = (jnp.exp(jnp.sum(diff_lambda_q1[l].astype(jnp.float32) * diff_lambda_k1[l].astype(jnp.float32)))
               - jnp.exp(jnp.sum(diff_lambda_q2[l].astype(jnp.float32) * diff_lambda_k2[l].astype(jnp.float32)))
               + lambda_init)
        dq = apply_rope(dq.reshape(b, s, DIFF_HEADS, 2, DIFF_HEAD_DIM))
        dk = apply_rope(dk.reshape(b, s, DIFF_HEADS, 2, DIFF_HEAD_DIM))
        dv = dv.reshape(b, s, DIFF_HEADS, DIFF_V_DIM)
        o_diff = diff_attention(dq, dk, dv, lam)
        o_diff = (rms_norm(o_diff, diff_subln_g[l]) * (1.0 - lambda_init)).reshape(b, s, DIFF_OUT)

        o = jnp.concatenate([o_mla, o_diff], axis=-1) @ w_out[l]
        x = x + rms_norm(o, mix_post_g[l])

        f = swiglu(rms_norm(x, ffn2_pre_g[l]), ffn2_w_gate[l], ffn2_w_up[l], ffn2_w_down[l])
        x = x + 0.5 * rms_norm(f, ffn2_post_g[l])
    return x
```

```cpp
#include <hip/hip_runtime.h>
#include <hip/hip_cooperative_groups.h>
#include <cstdio>
#include <cstdint>
namespace cg = cooperative_groups;
namespace pg8 {
#define PG8_LAS __attribute__((address_space(3)))
typedef unsigned short bf16_t;
typedef short bf16x8 __attribute__((ext_vector_type(8)));
typedef float f32x4 __attribute__((ext_vector_type(4)));
typedef unsigned u32x4 __attribute__((ext_vector_type(4)));
constexpr int BM = 256, BK = 64, HALF = 128, HTB = HALF * BK * 2  , STAGE_BYTES = 8 * HTB, NXCD = 8, WGM = 8;

__host__ __device__ __forceinline__ int lds_byte(int r, int c) { const int st = (r >> 4) * 2 + (c >> 5), rr = r & 15, cc = c & 31, ob = rr * 64 + cc * 2; return st * 1024 + (ob ^ (((ob >> 9) & 1) << 5)); }
__host__ __device__ __forceinline__ void stage_rc(int b, int& R, int& C) { const int st = b / 1024, sb = b % 1024, swz = sb ^ (((sb >> 9) & 1) << 5); R = (st >> 1) * 16 + swz / 64; C = (st & 1) * 32 + (swz % 64) / 2; }
__host__ __device__ __forceinline__ int perm32(int rho) { const int n = rho >> 4, i = rho & 15; return 8 * (i >> 2) + 4 * n + (i & 3); }

struct Unit { int pm, pn; };
struct Gemm { const bf16_t* A; const bf16_t* Bt; int M, N, K; int lda; };

struct StaticOrder {
    int nM, nN, nwg, G, c;
    __host__ __device__ __forceinline__ void init(int M, int N, int G_, int c_) { nM = M / BM; nN = N / BM; nwg = nM * nN; G = G_; c = c_; }
    __host__ __device__ __forceinline__ bool next(int i, Unit& u) const {
        const long L = (long)i * G + c; if (L >= nwg) return false;
        int wgid = (int)L; { const int q = nwg / NXCD, r = nwg % NXCD, xcd = wgid % NXCD, off = wgid / NXCD; wgid = (xcd < r ? xcd * (q + 1) : r * (q + 1) + (xcd - r) * q) + off; }
        const int nig = WGM * nN, gid = wgid / nig, fm = gid * WGM, gsz = (nM - fm) < WGM ? (nM - fm) : WGM;
        u.pm = fm + ((wgid % nig) % gsz); u.pn = (wgid % nig) / gsz; return true;
    }
    __device__ __forceinline__ void a_ready(const Unit&) const {}
    __device__ __forceinline__ void done(const Unit&) const {}
};

__device__ __forceinline__ unsigned cvt_pk_bf16(float lo, float hi) { unsigned r; asm volatile("v_cvt_pk_bf16_f32 %0, %1, %2" : "=v"(r) : "v"(lo), "v"(hi)); return r; }
template <bool RS> struct EpiBf16T {
    static constexpr bool PERM = true, AFTER_DRAIN = false;
    bf16_t* O; int ldc; const float* rowss; float* latss; const float* cs128; const float* cs64; bf16_t* KPE;
    template <bool R128> __device__ __forceinline__ void rope_tile(const f32x4 (&acc)[2][2][4][2], const Unit& u, int row0, int wc, int fq) const {
        const int ih = R128 ? 32 * (wc & 1) + 8 * fq : 8 * fq;
#pragma unroll
        for (int ai = 0; ai < 2; ++ai)
#pragma unroll
            for (int m = 0; m < 4; ++m) { const int row = row0 + ai * HALF + m * 16, pos = row & 2047;
                const float sc = 1.0f / sqrtf(rowss[row] * (1.0f / 2048.0f) + 1e-6f);
                const f32x4* cs; if constexpr (R128) cs = (const f32x4*)(cs128 + ((size_t)pos * 64 + ih) * 2); else cs = (const f32x4*)(cs64 + ((size_t)pos * 32 + ih) * 2);
                u32x4 w1, w2;
#pragma unroll
                for (int n = 0; n < 2; ++n) { const f32x4 x1 = acc[ai][0][m][n] * sc, x2 = acc[ai][1][m][n] * sc, c01 = cs[2 * n], c23 = cs[2 * n + 1];
                    const unsigned a0 = cvt_pk_bf16(x1[0] * c01[0] - x2[0] * c01[1], x1[1] * c01[2] - x2[1] * c01[3]), a1 = cvt_pk_bf16(x1[2] * c23[0] - x2[2] * c23[1], x1[3] * c23[2] - x2[3] * c23[3]);
                    const unsigned b0 = cvt_pk_bf16(x2[0] * c01[0] + x1[0] * c01[1], x2[1] * c01[2] + x1[1] * c01[3]), b1 = cvt_pk_bf16(x2[2] * c23[0] + x1[2] * c23[1], x2[3] * c23[2] + x1[3] * c23[3]);
                    if (n == 0) { w1.x = a0; w1.y = a1; w2.x = b0; w2.y = b1; } else { w1.z = a0; w1.w = a1; w2.z = b0; w2.w = b1; } }
                if constexpr (R128) { bf16_t* dst = O + (size_t)row * ldc + u.pn * BM + (wc >> 1) * 128 + ih; *(u32x4*)dst = w1; *(u32x4*)(dst + 64) = w2; }
                else { bf16_t* dst = KPE + (size_t)row * 64 + ih; *(u32x4*)dst = w1; *(u32x4*)(dst + 32) = w2; } }
    }
    __device__ __forceinline__ void operator()(const f32x4 (&acc)[2][2][4][2], const Unit& u, int wr, int wc, int fr, int fq) const {
        const int row0 = u.pm * BM + wr * 64 + fr; const int col0 = u.pn * BM + wc * 32 + 8 * fq;
        if constexpr (RS) {
            if (u.pn >= 4 && u.pn < 12) { rope_tile<true>(acc, u, row0, wc, fq); return; }
            if (u.pn == 16) { if (wc == 0) rope_tile<false>(acc, u, row0, wc, fq); return; }
        }
#pragma unroll
        for (int ai = 0; ai < 2; ++ai)
#pragma unroll
            for (int m = 0; m < 4; ++m) { bf16_t* rowp = O + (size_t)(row0 + ai * HALF + m * 16) * ldc + col0;
                float sc = 1.0f; if constexpr (RS) sc = 1.0f / sqrtf(rowss[row0 + ai * HALF + m * 16] * (1.0f / 2048.0f) + 1e-6f);
                float s2 = 0.f;
#pragma unroll
                for (int bj = 0; bj < 2; ++bj) { const f32x4 v0 = acc[ai][bj][m][0] * sc, v1 = acc[ai][bj][m][1] * sc;
                    u32x4 w; w.x = cvt_pk_bf16(v0[0], v0[1]); w.y = cvt_pk_bf16(v0[2], v0[3]); w.z = cvt_pk_bf16(v1[0], v1[1]); w.w = cvt_pk_bf16(v1[2], v1[3]);
                    *(u32x4*)(rowp + bj * HALF) = w;
                    if constexpr (RS) {
#pragma unroll
                        for (int k = 0; k < 4; ++k) { const float a = __uint_as_float(w[k] << 16), b = __uint_as_float(w[k] & 0xffff0000u); s2 += a * a + b * b; } } }
                if constexpr (RS) { if (u.pn < 4) { s2 += __shfl_xor(s2, 16); s2 += __shfl_xor(s2, 32);
                    if (fq == 0) (void)__hip_atomic_fetch_add(latss + (u.pn >> 1) * 8192 + row0 + ai * HALF + m * 16, s2, __ATOMIC_RELAXED, __HIP_MEMORY_SCOPE_AGENT); } } }
    }
};
typedef EpiBf16T<false> EpiBf16; typedef EpiBf16T<true> EpiBf16R;
struct EpiBf16Rs {
    static constexpr bool PERM = true, AFTER_DRAIN = false;
    bf16_t* O; int ldc; const PG8_LAS float* S;
    __device__ __forceinline__ void operator()(const f32x4 (&acc)[2][2][4][2], const Unit& u, int wr, int wc, int fr, int fq) const {
        const int row0 = u.pm * BM + wr * 64 + fr; const int col0 = u.pn * BM + wc * 32 + 8 * fq;
#pragma unroll
        for (int ai = 0; ai < 2; ++ai)
#pragma unroll
            for (int m = 0; m < 4; ++m) { bf16_t* rowp = O + (size_t)(row0 + ai * HALF + m * 16) * ldc + col0; const float sc = S[wr * 64 + fr + ai * HALF + m * 16];
#pragma unroll
                for (int bj = 0; bj < 2; ++bj) { const f32x4 v0 = acc[ai][bj][m][0] * sc, v1 = acc[ai][bj][m][1] * sc;
                    u32x4 w; w.x = cvt_pk_bf16(v0[0], v0[1]); w.y = cvt_pk_bf16(v0[2], v0[3]); w.z = cvt_pk_bf16(v1[0], v1[1]); w.w = cvt_pk_bf16(v1[2], v1[3]);
                    *(u32x4*)(rowp + bj * HALF) = w; } }
    }
};
__device__ __forceinline__ float silu_mul(float g, float u) { return g * u * __builtin_amdgcn_rcpf(1.0f + __builtin_amdgcn_exp2f(g * -1.4426950408889634f)); }
template <bool RS> struct EpiSwiGLUT {
    static constexpr bool PERM = true, AFTER_DRAIN = false;
    bf16_t* O; int ldc; const float* rowss;
    __device__ __forceinline__ void operator()(const f32x4 (&acc)[2][2][4][2], const Unit& u, int wr, int wc, int fr, int fq) const {
        const int row0 = u.pm * BM + wr * 64 + fr; const int col0 = u.pn * HALF + wc * 32 + 8 * fq;
#pragma unroll
        for (int ai = 0; ai < 2; ++ai)
#pragma unroll
            for (int m = 0; m < 4; ++m) { bf16_t* rowp = O + (size_t)(row0 + ai * HALF + m * 16) * ldc + col0;
                float sc = 1.0f; if constexpr (RS) sc = 1.0f / sqrtf(rowss[row0 + ai * HALF + m * 16] * (1.0f / 2048.0f) + 1e-6f);
                f32x4 g0 = acc[ai][0][m][0], g1 = acc[ai][0][m][1], u0 = acc[ai][1][m][0], u1 = acc[ai][1][m][1];
                if constexpr (RS) { g0 = g0 * sc; g1 = g1 * sc; u0 = u0 * sc; u1 = u1 * sc; }
                f32x4 e0 = g0 * -1.4426950408889634f, e1 = g1 * -1.4426950408889634f;
#pragma unroll
                for (int k = 0; k < 4; ++k) { e0[k] = __builtin_amdgcn_exp2f(e0[k]); e1[k] = __builtin_amdgcn_exp2f(e1[k]); }
                e0 = e0 + 1.0f; e1 = e1 + 1.0f;
#pragma unroll
                for (int k = 0; k < 4; ++k) { e0[k] = __builtin_amdgcn_rcpf(e0[k]); e1[k] = __builtin_amdgcn_rcpf(e1[k]); }
                const f32x4 o0 = (g0 * u0) * e0, o1 = (g1 * u1) * e1;
                u32x4 w; w.x = cvt_pk_bf16(o0[0], o0[1]); w.y = cvt_pk_bf16(o0[2], o0[3]); w.z = cvt_pk_bf16(o1[0], o1[1]); w.w = cvt_pk_bf16(o1[2], o1[3]);
                *(u32x4*)rowp = w; }
    }
};
typedef EpiSwiGLUT<false> EpiSwiGLU; typedef EpiSwiGLUT<true> EpiSwiGLUR;
struct EpiF32 {
    static constexpr bool PERM = false, AFTER_DRAIN = false;
    float* O; int ldc;
    __device__ __forceinline__ void operator()(const f32x4 (&acc)[2][2][4][2], const Unit& u, int wr, int wc, int fr, int fq) const {
        const int row0 = u.pm * BM + wr * 64 + fr; const int col0 = u.pn * BM + wc * 32 + 4 * fq;
#pragma unroll
        for (int ai = 0; ai < 2; ++ai)
#pragma unroll
            for (int m = 0; m < 4; ++m) { float* rowp = O + (size_t)(row0 + ai * HALF + m * 16) * ldc + col0;
#pragma unroll
                for (int bj = 0; bj < 2; ++bj)
#pragma unroll
                    for (int n = 0; n < 2; ++n) *(f32x4*)(rowp + bj * HALF + n * 16) = acc[ai][bj][m][n]; }
    }
};

struct PanelRms {
    float* xbuf;
    unsigned* cnt;
    int ntn; float inv_n, eps;
    __device__ __forceinline__ void publish(const f32x4 (&v)[2][2][4][2], const Unit& u, int wr, int wc, int fr, int fq, PG8_LAS unsigned char* lds, int wid, int lane) const {
        PG8_LAS float* P = (PG8_LAS float*)lds;
#pragma unroll
        for (int ai = 0; ai < 2; ++ai)
#pragma unroll
            for (int m = 0; m < 4; ++m) {
                float s = 0.f;
#pragma unroll
                for (int bj = 0; bj < 2; ++bj)
#pragma unroll
                    for (int n = 0; n < 2; ++n) { const f32x4 x = v[ai][bj][m][n]; s += (x[0] * x[0] + x[1] * x[1]) + (x[2] * x[2] + x[3] * x[3]); }
                s += __shfl_xor(s, 16); s += __shfl_xor(s, 32);
                if (fq == 0) P[(ai * HALF + wr * 64 + m * 16 + fr) * 4 + wc] = s;
            }
        asm volatile("s_waitcnt lgkmcnt(0)" ::: "memory"); __builtin_amdgcn_s_barrier(); asm volatile("" ::: "memory");
        const int row = wid * 32 + (lane & 31);
        if (lane < 32) {
            const float t = (P[row * 4 + 0] + P[row * 4 + 1]) + (P[row * 4 + 2] + P[row * 4 + 3]);
            __hip_atomic_store((unsigned*)xbuf + ((size_t)(u.pm * BM + row) * 8 + u.pn), __float_as_uint(t) | 1u, __ATOMIC_RELAXED, __HIP_MEMORY_SCOPE_AGENT);
        }
    }
    __device__ __forceinline__ void collect(const Unit& u, PG8_LAS unsigned char* lds, int wid, int lane) const {
        PG8_LAS float* S = (PG8_LAS float*)(lds + 4096);
        const int row = wid * 32 + (lane & 31);
        if (lane < 32) {
            const unsigned* slot = (const unsigned*)xbuf + (size_t)(u.pm * BM + row) * 8; unsigned w[8]; unsigned sp = 0;
            for (;;) { unsigned all = 1u;
#pragma unroll
                for (int k = 0; k < 8; ++k) { w[k] = (k < ntn) ? __hip_atomic_load(slot + k, __ATOMIC_RELAXED, __HIP_MEMORY_SCOPE_AGENT) : 1u; all &= w[k]; }
                if (all & 1u) break;
                __builtin_amdgcn_s_sleep(1); if (++sp > (1u << 20)) break; }
            float t = 0.f;
#pragma unroll
            for (int k = 0; k < 8; ++k) if (k < ntn) t += __uint_as_float(w[k]);
            S[row] = 1.0f / sqrtf(t * inv_n + eps);
        }
        asm volatile("s_waitcnt lgkmcnt(0)" ::: "memory"); __builtin_amdgcn_s_barrier(); asm volatile("" ::: "memory");
    }
};
typedef unsigned u32x2v __attribute__((ext_vector_type(2)));
__device__ __forceinline__ f32x4 raw_load4(const float* p) { return *(const f32x4*)p; }
__device__ __forceinline__ u32x2v raw_load4(const bf16_t* p) { return *(const u32x2v*)p; }
__device__ __forceinline__ f32x4 raw_cvt4(f32x4 r) { return r; }
__device__ __forceinline__ f32x4 raw_cvt4(u32x2v r) { return (f32x4){__uint_as_float(r.x << 16), __uint_as_float(r.x & 0xffff0000u), __uint_as_float(r.y << 16), __uint_as_float(r.y & 0xffff0000u)}; }
template <typename TB, typename TO, bool STAT>
struct EpiRmsRes2 {
    static constexpr bool PERM = false, AFTER_DRAIN = true;
    const TB* base; TO* out; int ldc; const float* g; float coef; float* rowss; PanelRms st;
    __device__ __forceinline__ void fused(f32x4 (&acc)[2][2][4][2], const Unit& u, int wr, int wc, int fr, int fq, PG8_LAS unsigned char* lds, int wid, int lane) const {
        const PG8_LAS float* S = (const PG8_LAS float*)(lds + 4096);
        const int col0 = u.pn * BM + wc * 32 + 4 * fq;
        st.publish(acc, u, wr, wc, fr, fq, lds, wid, lane);
        decltype(raw_load4(base)) pre[4][2][2];
#pragma unroll
        for (int m = 0; m < 4; ++m) { const size_t off = (size_t)(u.pm * BM + wr * 64 + m * 16 + fr) * ldc + col0;
#pragma unroll
            for (int bj = 0; bj < 2; ++bj)
#pragma unroll
                for (int n = 0; n < 2; ++n) pre[m][bj][n] = raw_load4(base + off + bj * HALF + n * 16); }
        st.collect(u, lds, wid, lane);
        f32x4 gv[2][2];
#pragma unroll
        for (int bj = 0; bj < 2; ++bj)
#pragma unroll
            for (int n = 0; n < 2; ++n) gv[bj][n] = *(const f32x4*)(g + col0 + bj * HALF + n * 16) * coef;
#pragma unroll
        for (int ai = 0; ai < 2; ++ai)
#pragma unroll
            for (int m = 0; m < 4; ++m) { const int r = ai * HALF + wr * 64 + m * 16 + fr; const float rs = S[r]; const size_t off = (size_t)(u.pm * BM + r) * ldc + col0; float s2 = 0.f;
#pragma unroll
                for (int bj = 0; bj < 2; ++bj)
#pragma unroll
                    for (int n = 0; n < 2; ++n) { const f32x4 bs = raw_cvt4(ai == 0 ? pre[m][bj][n] : raw_load4(base + off + bj * HALF + n * 16));
                        const f32x4 y = bs + acc[ai][bj][m][n] * rs * gv[bj][n];
                        if constexpr (sizeof(TO) == 2) { u32x2v w; w.x = cvt_pk_bf16(y[0], y[1]); w.y = cvt_pk_bf16(y[2], y[3]); *(u32x2v*)(out + off + bj * HALF + n * 16) = w;
                            if constexpr (STAT) { const f32x4 yr = raw_cvt4(w); s2 += (yr[0] * yr[0] + yr[1] * yr[1]) + (yr[2] * yr[2] + yr[3] * yr[3]); } }
                        else { __builtin_nontemporal_store(y, (f32x4*)(out + off + bj * HALF + n * 16)); if constexpr (STAT) s2 += (y[0] * y[0] + y[1] * y[1]) + (y[2] * y[2] + y[3] * y[3]); } }
                if constexpr (STAT) { s2 += __shfl_xor(s2, 16); s2 += __shfl_xor(s2, 32);
                    if (fq == 0) (void)__hip_atomic_fetch_add(rowss + (u.pm * BM + r), s2, __ATOMIC_RELAXED, __HIP_MEMORY_SCOPE_AGENT); }
                if (m & 1) asm volatile("" ::: "memory"); }
    }
};
typedef EpiRmsRes2<float, bf16_t, true> EpiResA; typedef EpiRmsRes2<bf16_t, bf16_t, true> EpiResB; typedef EpiRmsRes2<bf16_t, float, false> EpiResC;

template <class Epi, class Sched, bool ALIGN_EPI = false, bool SP2 = false>
__device__ __forceinline__ void gemm_phase(PG8_LAS unsigned char* lds, const Gemm g, const Sched& S, const Epi& E) {
    int tid_ = threadIdx.x; asm volatile("" : "+v"(tid_));
    const int tid = tid_, wid = __builtin_amdgcn_readfirstlane(tid >> 6), lane = tid & 63, wr = wid >> 2, wc = wid & 3, fr = lane & 15, fq = lane >> 4;
    const int K = g.K, nt = K / BK, lda = g.lda ? g.lda : K;
    unsigned voffA[2], voffB[2];
#pragma unroll
    for (int i = 0; i < 2; ++i) { int R, C; stage_rc(tid * 16 + i * 8192, R, C); const int Rb = Epi::PERM ? ((R & ~31) + perm32(R & 31)) : R;
        voffA[i] = (unsigned)(R * lda + C) * 2u; voffB[i] = (unsigned)(Rb * K + C) * 2u; }
    const size_t kstep = (size_t)(BK * 2);
    const size_t hstep = (size_t)HALF * K * 2;
    const size_t hstepA = (size_t)HALF * lda * 2, tstepA = 2 * hstepA;
    const size_t tstep = 2 * hstep;
    const unsigned ldsw = (unsigned)wid * 1024u;
    const int aoff = lds_byte(wr * 64 + fr, fq * 8), boff = lds_byte(wc * 32 + fr, fq * 8);
#define PG8_SA(b, h) (((b) * 2 + (h)) * HTB)
#define PG8_SB(b, h) ((4 + (b) * 2 + (h)) * HTB)
#define PG8_STAGE(bufoff, gbase, voff) do { _Pragma("unroll") for (int _i = 0; _i < 2; ++_i) \
        __builtin_amdgcn_global_load_lds((const unsigned*)((const char*)(gbase) + (voff)[_i]), (PG8_LAS unsigned*)(lds + (bufoff) + ldsw + _i * 8192), 16, 0, 0); } while (0)
#define PG8_LDA(dst, b, h) do { _Pragma("unroll") for (int m = 0; m < 4; ++m) _Pragma("unroll") for (int k = 0; k < 2; ++k) dst[m][k] = *(const PG8_LAS bf16x8*)(lds + PG8_SA(b, h) + aoff + m * 2048 + k * 1024); } while (0)
#define PG8_LDB(dst, b, h) do { _Pragma("unroll") for (int n = 0; n < 2; ++n) _Pragma("unroll") for (int k = 0; k < 2; ++k) dst[n][k] = *(const PG8_LAS bf16x8*)(lds + PG8_SB(b, h) + boff + n * 2048 + k * 1024); } while (0)
#define PG8_MMA(ai, bj, At, Bt) do { __builtin_amdgcn_s_setprio(1); _Pragma("unroll") for (int m = 0; m < 4; ++m) _Pragma("unroll") for (int n = 0; n < 2; ++n) _Pragma("unroll") for (int k = 0; k < 2; ++k) \
        acc[ai][bj][m][n] = __builtin_amdgcn_mfma_f32_16x16x32_bf16(Bt[n][k], At[m][k], acc[ai][bj][m][n], 0, 0, 0); __builtin_amdgcn_s_setprio(0); } while (0)
#define PG8_WAIT_V(n) asm volatile("s_waitcnt vmcnt(" #n ")" ::: "memory")
#define PG8_WAIT_L(n) asm volatile("s_waitcnt lgkmcnt(" #n ")" ::: "memory")
#define PG8_BAR __builtin_amdgcn_s_barrier()
#define PG8_SCHED __builtin_amdgcn_sched_barrier(0)
    Unit cur, nxt; int ui = 0;
    if (!S.next(0, cur)) return;
    f32x4 acc[2][2][4][2];
#pragma unroll
    for (int a = 0; a < 2; ++a)
#pragma unroll
        for (int b = 0; b < 2; ++b)
#pragma unroll
            for (int m = 0; m < 4; ++m)
#pragma unroll
                for (int n = 0; n < 2; ++n) acc[a][b][m][n] = (f32x4){0.f, 0.f, 0.f, 0.f};
    bf16x8 At[4][2], B0[2][2], B1[2][2];
    const char* cA = (const char*)g.A + (size_t)cur.pm * tstepA; const char* cB = (const char*)g.Bt + (size_t)cur.pn * tstep;
    S.a_ready(cur);
    if constexpr (SP2) {
        PG8_STAGE(PG8_SB(0, 0), cB, voffB); PG8_STAGE(PG8_SB(0, 1), cB + hstep, voffB); PG8_STAGE(PG8_SA(0, 0), cA, voffA); PG8_STAGE(PG8_SA(0, 1), cA + hstepA, voffA);
        if (wr == 1) PG8_BAR;
        PG8_WAIT_V(2); PG8_BAR;
        PG8_STAGE(PG8_SB(1, 0), cB + kstep, voffB); PG8_STAGE(PG8_SA(1, 0), cA + kstep, voffA); PG8_STAGE(PG8_SB(1, 1), cB + hstep + kstep, voffB);
        PG8_WAIT_V(6); PG8_BAR;
    } else {
        PG8_STAGE(PG8_SB(0, 0), cB, voffB); PG8_STAGE(PG8_SA(0, 0), cA, voffA); PG8_STAGE(PG8_SB(0, 1), cB + hstep, voffB); PG8_STAGE(PG8_SA(0, 1), cA + hstepA, voffA);
        if (wr == 1) PG8_BAR;
        PG8_WAIT_V(4); PG8_BAR;
        PG8_STAGE(PG8_SB(1, 0), cB + kstep, voffB); PG8_STAGE(PG8_SA(1, 0), cA + kstep, voffA); PG8_STAGE(PG8_SB(1, 1), cB + hstep + kstep, voffB);
        PG8_WAIT_V(6); PG8_BAR;
    }
    for (;;) {
        const bool has_next = S.next(ui + 1, nxt);
        const char* nA = has_next ? (const char*)g.A + (size_t)nxt.pm * tstepA : cA; const char* nB = has_next ? (const char*)g.Bt + (size_t)nxt.pn * tstep : cB;
        for (int t = 0; t < nt; t += 2) {
            const bool last = (t == nt - 2);
            const char* a1 = cA + (size_t)(t + 1) * kstep;
            const char* a2 = last ? nA : cA + (size_t)(t + 2) * kstep; const char* b2 = last ? nB : cB + (size_t)(t + 2) * kstep;
            const char* a3 = a2 + kstep; const char* b3 = b2 + kstep;
            if (last && has_next) S.a_ready(nxt);
            if constexpr (SP2) {
            PG8_LDB(B0, 0, 0); PG8_LDB(B1, 0, 1); PG8_SCHED; PG8_LDA(At, 0, 0); PG8_STAGE(PG8_SA(1, 1), a1 + hstepA, voffA);
            PG8_WAIT_V(8); PG8_WAIT_L(0); PG8_BAR; PG8_MMA(0, 0, At, B0); PG8_MMA(0, 1, At, B1); PG8_BAR; PG8_SCHED;
            PG8_LDA(At, 0, 1); PG8_STAGE(PG8_SB(0, 0), b2, voffB); PG8_STAGE(PG8_SB(0, 1), b2 + hstep, voffB); PG8_STAGE(PG8_SA(0, 0), a2, voffA);
            PG8_WAIT_V(8); PG8_WAIT_L(0); PG8_BAR; PG8_MMA(1, 0, At, B0); PG8_MMA(1, 1, At, B1); PG8_BAR; PG8_SCHED;
            PG8_LDB(B0, 1, 0); PG8_LDB(B1, 1, 1); PG8_SCHED; PG8_LDA(At, 1, 0); PG8_STAGE(PG8_SA(0, 1), a2 + hstepA, voffA);
            PG8_WAIT_V(8); PG8_WAIT_L(0); PG8_BAR; PG8_MMA(0, 0, At, B0); PG8_MMA(0, 1, At, B1); PG8_BAR; PG8_SCHED;
            PG8_LDA(At, 1, 1); PG8_STAGE(PG8_SB(1, 0), b3, voffB); PG8_STAGE(PG8_SB(1, 1), b3 + hstep, voffB); PG8_STAGE(PG8_SA(1, 0), a3, voffA);
            PG8_WAIT_V(8); PG8_WAIT_L(0); PG8_BAR; PG8_MMA(1, 0, At, B0); PG8_MMA(1, 1, At, B1); PG8_BAR; PG8_SCHED;
            } else {
            PG8_LDB(B0, 0, 0); PG8_SCHED; PG8_LDA(At, 0, 0); PG8_STAGE(PG8_SA(1, 1), a1 + hstepA, voffA);
            PG8_WAIT_L(8); PG8_BAR; PG8_WAIT_L(0); PG8_MMA(0, 0, At, B0); PG8_BAR; PG8_SCHED;
            PG8_LDB(B1, 0, 1); PG8_STAGE(PG8_SB(0, 0), b2, voffB);
            PG8_BAR; PG8_WAIT_L(0); PG8_MMA(0, 1, At, B1); PG8_BAR;
            PG8_LDA(At, 0, 1); PG8_STAGE(PG8_SA(0, 0), a2, voffA);
            PG8_BAR; PG8_WAIT_L(0); PG8_MMA(1, 0, At, B0); PG8_BAR; PG8_SCHED;
            PG8_STAGE(PG8_SB(0, 1), b2 + hstep, voffB);
            PG8_WAIT_V(6); PG8_BAR; PG8_MMA(1, 1, At, B1); PG8_BAR;
            PG8_LDB(B0, 1, 0); PG8_SCHED; PG8_LDA(At, 1, 0); PG8_STAGE(PG8_SA(0, 1), a2 + hstepA, voffA);
            PG8_WAIT_L(8); PG8_BAR; PG8_WAIT_L(0); PG8_MMA(0, 0, At, B0); PG8_BAR; PG8_SCHED;
            PG8_LDB(B1, 1, 1); PG8_STAGE(PG8_SB(1, 0), b3, voffB);
            PG8_BAR; PG8_WAIT_L(0); PG8_MMA(0, 1, At, B1); PG8_BAR;
            PG8_LDA(At, 1, 1); PG8_STAGE(PG8_SA(1, 0), a3, voffA);
            PG8_BAR; PG8_WAIT_L(0); PG8_MMA(1, 0, At, B0); PG8_BAR; PG8_SCHED;
            PG8_STAGE(PG8_SB(1, 1), b3 + hstep, voffB);
            PG8_WAIT_V(6); PG8_BAR; PG8_MMA(1, 1, At, B1); PG8_BAR;
            }
        }
        if constexpr (ALIGN_EPI) { if (wr == 0) PG8_BAR; }
        if constexpr (!Epi::AFTER_DRAIN) { E(acc, cur, wr, wc, fr, fq); S.done(cur); }
        if (!has_next) break;
#pragma unroll
        for (int a = 0; a < 2; ++a)
#pragma unroll
            for (int b = 0; b < 2; ++b)
#pragma unroll
                for (int m = 0; m < 4; ++m)
#pragma unroll
                    for (int n = 0; n < 2; ++n) acc[a][b][m][n] = (f32x4){0.f, 0.f, 0.f, 0.f};
        cur = nxt; cA = nA; cB = nB; ++ui;
        if constexpr (ALIGN_EPI) { if (wr == 1) PG8_BAR; }
    }
    PG8_WAIT_V(0);
    if constexpr (!ALIGN_EPI) { if (wr == 0) PG8_BAR; }
    PG8_BAR;
    if constexpr (Epi::AFTER_DRAIN) { E.fused(acc, cur, wr, wc, fr, fq, lds, wid, lane); S.done(cur); }
#undef PG8_SA
#undef PG8_SB
#undef PG8_STAGE
#undef PG8_LDA
#undef PG8_LDB
#undef PG8_MMA
#undef PG8_WAIT_V
#undef PG8_WAIT_L
#undef PG8_BAR
#undef PG8_SCHED
}
}
namespace att {
typedef unsigned short bf16_t;
using bf16x8 = __attribute__((ext_vector_type(8))) short;
using s16x4  = __attribute__((ext_vector_type(4))) short;
using f32x16 = __attribute__((ext_vector_type(16))) float;
using f32x4  = __attribute__((ext_vector_type(4))) float;
using u32x4  = __attribute__((ext_vector_type(4))) unsigned;
constexpr int NW = 8, QBLK = 32, KVBLK = 64;
constexpr int SHM_V = KVBLK * 128 * 2, SHM_K = KVBLK * 128 * 2, SHM_KP = KVBLK * 64 * 2;
constexpr int OFF_V = 0, OFF_K = 2 * SHM_V, OFF_KP = OFF_K + 2 * SHM_K, OFF_WS = OFF_KP + 2 * SHM_KP, OFF_QP = OFF_WS + NW * 64 * 4, LDS_BYTES = OFF_QP + NW * 4096;
constexpr float THR = 8.f;
#define KSWZ(row, colB) ((row) * 256 + ((colB) ^ (((((row) & 7) | (((row) >> 1) & 8))) << 4)))
#define KPSWZ(row, colB) ((row) * 128 + ((colB) ^ ((((row) >> 1) & 7) << 4)))
#define SBAR() __builtin_amdgcn_sched_barrier(0)
__device__ __forceinline__ int crow(int r, int hi) { return (r & 3) + 8 * (r >> 2) + 4 * hi; }
__device__ __forceinline__ unsigned cvtpk(float lo, float hi) { unsigned r; asm volatile("v_cvt_pk_bf16_f32 %0, %1, %2" : "=v"(r) : "v"(lo), "v"(hi)); return r; }
__device__ __forceinline__ float bf2f(short s) { return __uint_as_float(((unsigned)(unsigned short)s) << 16); }

constexpr float THRL = THR * 1.4426950408889634f;
template <bool FIRST>
__device__ __forceinline__ void partialSM(f32x16& p0, f32x16& p1, float& m_reg, float& alpha) {
  float pmax = fmaxf(p0[0], p1[0]);
#pragma unroll
  for (int r = 1; r < 16; ++r) pmax = __builtin_fmaxf(__builtin_fmaxf(pmax, p0[r]), p1[r]);
  { auto rr = __builtin_amdgcn_permlane32_swap(__float_as_uint(pmax), __float_as_uint(pmax), false, false);
    pmax = fmaxf(__uint_as_float(rr[0]), __uint_as_float(rr[1])); }
  alpha = 1.f;
  if (FIRST || !__builtin_expect(__all(pmax <= THRL), 1)) {
    const float d = FIRST ? pmax : fmaxf(pmax, 0.f);
    m_reg += d; if (!FIRST) alpha = __builtin_amdgcn_exp2f(-d);
#pragma unroll
    for (int r = 0; r < 16; ++r) { p0[r] -= d; p1[r] -= d; }
  }
#pragma unroll
  for (int r = 0; r < 16; ++r) p0[r] = __builtin_amdgcn_exp2f(p0[r]);
}
__device__ __forceinline__ void finishSM(f32x16& p0, f32x16& p1, float alpha, float& l_reg, bf16x8& pa0, bf16x8& pa1, bf16x8& pa2, bf16x8& pa3) {
#pragma unroll
  for (int r = 0; r < 16; ++r) p1[r] = __builtin_amdgcn_exp2f(p1[r]);
  float ps = 0;
#pragma unroll
  for (int r = 0; r < 16; ++r) ps += p0[r];
#pragma unroll
  for (int r = 0; r < 16; ++r) ps += p1[r];
  { auto rr = __builtin_amdgcn_permlane32_swap(__float_as_uint(ps), __float_as_uint(ps), false, false);
    ps = __uint_as_float(rr[0]) + __uint_as_float(rr[1]); }
  l_reg = l_reg * alpha + ps;
#define PK4(P, BASE, OUT) do { unsigned a0 = cvtpk(P[BASE + 0], P[BASE + 1]), a1 = cvtpk(P[BASE + 2], P[BASE + 3]);   \
    unsigned b0 = cvtpk(P[BASE + 4], P[BASE + 5]), b1 = cvtpk(P[BASE + 6], P[BASE + 7]);                              \
    auto r0 = __builtin_amdgcn_permlane32_swap(a0, b0, false, false); auto r1 = __builtin_amdgcn_permlane32_swap(a1, b1, false, false); \
    u32x4 w = {r0[0], r1[0], r0[1], r1[1]}; OUT = *reinterpret_cast<bf16x8*>(&w); } while (0)
  PK4(p0, 0, pa0); PK4(p0, 8, pa1); PK4(p1, 0, pa2); PK4(p1, 8, pa3);
#undef PK4
}
template <bool MLA>
__device__ __forceinline__ void qkt(f32x16& p0, f32x16& p1, const char* Ks, const char* Kps, const char* Qps, const bf16x8* qr, int r32, int hi, float negm) {
#pragma unroll
  for (int r = 0; r < 16; ++r) { p0[r] = negm; p1[r] = negm; }
  asm volatile("" : "+v"(r32), "+v"(hi));
#pragma unroll
  for (int d0 = 0; d0 < 8; ++d0) { int cb = (d0 * 16 + hi * 8) * 2;
    bf16x8 b0 = *reinterpret_cast<const bf16x8*>(Ks + KSWZ(r32, cb));
    bf16x8 b1 = *reinterpret_cast<const bf16x8*>(Ks + KSWZ(32 + r32, cb));
    p0 = __builtin_amdgcn_mfma_f32_32x32x16_bf16(b0, qr[d0], p0, 0, 0, 0);
    p1 = __builtin_amdgcn_mfma_f32_32x32x16_bf16(b1, qr[d0], p1, 0, 0, 0); }
  if constexpr (MLA) {
    SBAR();
#pragma unroll
    for (int d0 = 0; d0 < 4; ++d0) { int cb = (d0 * 16 + hi * 8) * 2;
      bf16x8 b0 = *reinterpret_cast<const bf16x8*>(Kps + KPSWZ(r32, cb));
      bf16x8 b1 = *reinterpret_cast<const bf16x8*>(Kps + KPSWZ(32 + r32, cb));
      const bf16x8 qp = *reinterpret_cast<const bf16x8*>(Qps + KPSWZ(r32, cb));
      p0 = __builtin_amdgcn_mfma_f32_32x32x16_bf16(b0, qp, p0, 0, 0, 0);
      p1 = __builtin_amdgcn_mfma_f32_32x32x16_bf16(b1, qp, p1, 0, 0, 0); }
  }
}
__device__ __forceinline__ int v_st(int k, int c) { const int kk = (k & ~0xC) | ((k & 4) << 1) | ((k & 8) >> 1); return ((kk >> 3) * 4 + (c >> 5)) * 512 + ((kk & 7) * 32 + (c & 31)) * 2; }
__device__ __forceinline__ int v_rd_base(int lane) { return ((lane & 3) << 3) | (((lane >> 2) & 3) << 6) | (((lane >> 4) & 1) << 5) | (((lane >> 5) & 1) << 8); }
constexpr int v_rd_off(int d0, int ks, int half) { return d0 * 512 + ks * 4096 + half * 2048; }
template <int OFF> __device__ __forceinline__ s16x4 tr_read(int vb) {
  s16x4 r; asm volatile("ds_read_b64_tr_b16 %0, %1 offset:%2" : "=&v"(r) : "v"(vb), "i"(OFF) : "memory"); return r;
}
template <int D0> __device__ __forceinline__ void pv_one(f32x16& od, int vb, bf16x8 pa0, bf16x8 pa1, bf16x8 pa2, bf16x8 pa3) {
  const s16x4 l0 = tr_read<v_rd_off(D0, 0, 0)>(vb), h0 = tr_read<v_rd_off(D0, 0, 1)>(vb), l1 = tr_read<v_rd_off(D0, 1, 0)>(vb), h1 = tr_read<v_rd_off(D0, 1, 1)>(vb);
  const s16x4 l2 = tr_read<v_rd_off(D0, 2, 0)>(vb), h2 = tr_read<v_rd_off(D0, 2, 1)>(vb), l3 = tr_read<v_rd_off(D0, 3, 0)>(vb), h3 = tr_read<v_rd_off(D0, 3, 1)>(vb);
  asm volatile("s_waitcnt lgkmcnt(0)" ::: "memory"); SBAR();
#define PK(L, H) (bf16x8){L[0], L[1], L[2], L[3], H[0], H[1], H[2], H[3]}
  od = __builtin_amdgcn_mfma_f32_32x32x16_bf16(pa0, PK(l0, h0), od, 0, 0, 0);
  od = __builtin_amdgcn_mfma_f32_32x32x16_bf16(pa1, PK(l1, h1), od, 0, 0, 0);
  od = __builtin_amdgcn_mfma_f32_32x32x16_bf16(pa2, PK(l2, h2), od, 0, 0, 0);
  od = __builtin_amdgcn_mfma_f32_32x32x16_bf16(pa3, PK(l3, h3), od, 0, 0, 0);
#undef PK
}
__device__ __forceinline__ void pv_d0(f32x16* o, int vb, bf16x8 pa0, bf16x8 pa1, bf16x8 pa2, bf16x8 pa3) {
  pv_one<0>(o[0], vb, pa0, pa1, pa2, pa3); pv_one<1>(o[1], vb, pa0, pa1, pa2, pa3); pv_one<2>(o[2], vb, pa0, pa1, pa2, pa3); pv_one<3>(o[3], vb, pa0, pa1, pa2, pa3);
}
__device__ __forceinline__ void store_o(float* p, float v) { *p = v; }
__device__ __forceinline__ void store_o(bf16_t* p, float v) { unsigned u = __float_as_uint(v); *p = (bf16_t)((u + 0x7fffu + ((u >> 16) & 1u)) >> 16); }

template <bool MLA, typename TO, int LDQ, int LDK, int LDV, int LDO>
__device__ __forceinline__ void attn_unit(const bf16_t* __restrict__ Qb, const bf16_t* __restrict__ Kh, const bf16_t* __restrict__ Kpe, const bf16_t* __restrict__ Vh,
                                          TO* __restrict__ Ob, const int c0, const int pos0, const float* __restrict__ cs64, char* lds) {
  constexpr int NQ = 8;
  constexpr float SCALE = MLA ? 0.07216878364870322f : 0.08838834764831845f;
  constexpr float C = SCALE * 1.4426950408889634f, THRS = THR / SCALE;
  const int tid = threadIdx.x, wid = tid >> 6, lane = tid & 63, r32 = lane & 31, hi = lane >> 5;
  char* V_lds = lds + OFF_V; char* K_lds = lds + OFF_K; char* KP_lds = lds + OFF_KP; char* QP_lds = lds + OFF_QP + wid * 4096;
  float* ws = (float*)(lds + OFF_WS) + wid * 64; float* li_l = ws; float* al_l = ws + 32;
  float m_reg = 0.f, l_reg = 0; f32x16 o[4] = {}; bf16x8 qr[NQ];
  const int NT = c0 + 4, jmax = c0 + (wid >> 1);
  const bf16_t* Qw = Qb + (long)(wid * QBLK + r32) * LDQ + hi * 8;
#pragma unroll
  for (int d0 = 0; d0 < NQ; ++d0) qr[d0] = *reinterpret_cast<const bf16x8*>(Qw + d0 * 16);
  if constexpr (MLA) {
    const int pos = pos0 + wid * QBLK + r32;
#pragma unroll
    for (int a = 0; a < 2; ++a) {
      const f32x4* t = reinterpret_cast<const f32x4*>(cs64 + ((long)pos * 32 + 16 * a + 8 * hi) * 2);
      const bf16x8 x1 = *reinterpret_cast<const bf16x8*>(Qw + 128 + a * 16), x2 = *reinterpret_cast<const bf16x8*>(Qw + 128 + (a + 2) * 16); u32x4 w1, w2;
#pragma unroll
      for (int jj = 0; jj < 4; ++jj) { const f32x4 cs = t[jj];
        const float a0 = bf2f(x1[2 * jj]), a1 = bf2f(x1[2 * jj + 1]), b0 = bf2f(x2[2 * jj]), b1 = bf2f(x2[2 * jj + 1]);
        w1[jj] = cvtpk(a0 * cs[0] - b0 * cs[1], a1 * cs[2] - b1 * cs[3]);
        w2[jj] = cvtpk(b0 * cs[0] + a0 * cs[1], b1 * cs[2] + a1 * cs[3]); }
      *reinterpret_cast<u32x4*>(QP_lds + KPSWZ(r32, (a * 16 + hi * 8) * 2)) = w1; *reinterpret_cast<u32x4*>(QP_lds + KPSWZ(r32, ((a + 2) * 16 + hi * 8) * 2)) = w2;
    }
  }
  const int sr = tid >> 4, sc = (tid & 15) * 8, vst0 = v_st(sr, sc), vst1 = v_st(32 + sr, sc);
  const int kpr = tid >> 3, kpc = (tid & 7) * 8;
  const int vb0 = (int)(uintptr_t)V_lds + v_rd_base(lane);
  bf16x8 vs0, vs1, ks0, ks1, kp0;
#define SLOAD(k0) do { vs0 = *reinterpret_cast<const bf16x8*>(&Vh[(long)((k0) + sr) * LDV + sc]); vs1 = *reinterpret_cast<const bf16x8*>(&Vh[(long)((k0) + 32 + sr) * LDV + sc]); \
    ks0 = *reinterpret_cast<const bf16x8*>(&Kh[(long)((k0) + sr) * LDK + sc]); ks1 = *reinterpret_cast<const bf16x8*>(&Kh[(long)((k0) + 32 + sr) * LDK + sc]); \
    if constexpr (MLA) kp0 = *reinterpret_cast<const bf16x8*>(&Kpe[(long)((k0) + kpr) * 64 + kpc]); } while (0)
#define SWRITE(b) do { *(bf16x8*)(V_lds + (b) * SHM_V + vst0) = vs0; *(bf16x8*)(V_lds + (b) * SHM_V + vst1) = vs1; { int kc = sc * 2; \
    *(bf16x8*)(K_lds + (b) * SHM_K + KSWZ(sr, kc)) = ks0; *(bf16x8*)(K_lds + (b) * SHM_K + KSWZ(32 + sr, kc)) = ks1; } \
    if constexpr (MLA) *(bf16x8*)(KP_lds + (b) * SHM_KP + KPSWZ(kpr, kpc * 2)) = kp0; } while (0)
#define SWAIT() asm volatile("s_waitcnt vmcnt(0)" ::: "memory")
#define RESC(a) do { if (__any((a) < 1.f)) { if (hi == 0) al_l[r32] = (a); asm volatile("s_waitcnt lgkmcnt(0)" ::: "memory"); \
    _Pragma("unroll") for (int d = 0; d < 4; ++d) _Pragma("unroll") for (int r = 0; r < 16; ++r) o[d][r] *= al_l[crow(r, hi)]; } } while (0)
#define MASKF(P0, P1) do { _Pragma("unroll") for (int r = 0; r < 16; ++r) { P0[r] = -1e30f; P1[r] = -1e30f; } } while (0)
#define MASKT(P0, P1, j) do { if ((j) > jmax) { _Pragma("unroll") for (int r = 0; r < 16; ++r) { P0[r] = -1e30f; P1[r] = -1e30f; } } } while (0)
  f32x16 pA0, pA1, pB0, pB1; float mnA, mnB, alA, alB; bf16x8 pa0, pa1, pa2, pa3;
  SLOAD(0); SWAIT(); SWRITE(0); __syncthreads();
  qkt<MLA>(pA0, pA1, K_lds, KP_lds, QP_lds, qr, r32, hi, 0.f); partialSM<true>(pA0, pA1, m_reg, alA);
  SLOAD(KVBLK);
  SWAIT(); SWRITE(1); __syncthreads();
  for (int j = 1; j + 1 < NT; j += 2) {
    SBAR(); if (j <= jmax) qkt<MLA>(pB0, pB1, K_lds + SHM_K, KP_lds + SHM_KP, QP_lds, qr, r32, hi, -m_reg); else MASKF(pB0, pB1);
    finishSM(pA0, pA1, alA, l_reg, pa0, pa1, pa2, pa3); SBAR();
    SLOAD((j + 1) * KVBLK); SBAR();
    pv_d0(o, vb0, pa0, pa1, pa2, pa3); partialSM<false>(pB0, pB1, m_reg, alB);
    __syncthreads(); SWAIT(); SWRITE(0);
    RESC(alB); __syncthreads();
    SBAR(); if (j + 1 <= jmax) qkt<MLA>(pA0, pA1, K_lds, KP_lds, QP_lds, qr, r32, hi, -m_reg); else MASKF(pA0, pA1);
    finishSM(pB0, pB1, alB, l_reg, pa0, pa1, pa2, pa3); SBAR();
    SLOAD((j + 2) * KVBLK); SBAR();
    pv_d0(o, vb0 + SHM_V, pa0, pa1, pa2, pa3); partialSM<false>(pA0, pA1, m_reg, alA);
    __syncthreads(); SWAIT(); SWRITE(1);
    RESC(alA); __syncthreads();
  }
  SBAR(); if (NT - 1 <= jmax) qkt<MLA>(pB0, pB1, K_lds + SHM_K, KP_lds + SHM_KP, QP_lds, qr, r32, hi, -m_reg); else MASKF(pB0, pB1);
  finishSM(pA0, pA1, alA, l_reg, pa0, pa1, pa2, pa3); SBAR();
  pv_d0(o, vb0, pa0, pa1, pa2, pa3); partialSM<false>(pB0, pB1, m_reg, alB);
  __syncthreads(); RESC(alB);
  finishSM(pB0, pB1, alB, l_reg, pa0, pa1, pa2, pa3); SBAR();
  pv_d0(o, vb0 + SHM_V, pa0, pa1, pa2, pa3);
  if (hi == 0) li_l[r32] = l_reg; asm volatile("s_waitcnt lgkmcnt(0)" ::: "memory");
  float rli[16];
#pragma unroll
  for (int r = 0; r < 16; ++r) rli[r] = __builtin_amdgcn_rcpf(li_l[crow(r, hi)]);
  TO* Ow = Ob + (long)(wid * QBLK) * LDO;
#pragma unroll
  for (int r = 0; r < 16; ++r) { const int orow = crow(r, hi);
#pragma unroll
    for (int d0 = 0; d0 < 4; ++d0) store_o(Ow + (long)orow * LDO + d0 * 32 + r32, o[d0][r] * rli[r]); }
  __syncthreads();
#undef SLOAD
#undef SWRITE
#undef SWAIT
#undef RESC
#undef MASKT
#undef MASKF
}
#undef SBAR
}
#ifndef MK_N_LAUNCHES
#define MK_N_LAUNCHES 1
#endif
constexpr int N_PHASES = 14;
constexpr int NWAVES = 8, NTHR = NWAVES * 64;
constexpr int M = 8192, DM = 2048, FF = 5632, SEQ = 2048, NIN = 4352, NGU = 2 * FF;
constexpr int QRANK = 512, NUQ = 1536, NUKV = 2048;
constexpr float EPS = 1e-6f;
typedef unsigned short bf16;
typedef float f32x4 __attribute__((ext_vector_type(4)));
typedef short bf16x8 __attribute__((ext_vector_type(8)));
typedef unsigned v4u __attribute__((ext_vector_type(4)));
typedef unsigned v2u __attribute__((ext_vector_type(2)));
#define LAS __attribute__((address_space(3)))
#define LDS_WAIT() asm volatile("s_waitcnt lgkmcnt(0)" ::: "memory")

constexpr size_t MiB = 1u << 20;
constexpr size_t WS_CTL = 0, WS_CS64 = 1 * MiB, WS_CS128 = 1 * MiB + 512 * 1024;
constexpr size_t WS_WGU1 = 3 * MiB, WS_WD1 = 47 * MiB, WS_WIN = 69 * MiB, WS_WUQ = 86 * MiB, WS_WUKV = 88 * MiB, WS_WOUT = 90 * MiB, WS_WGU2 = 98 * MiB, WS_WD2 = 142 * MiB;
constexpr size_t WS_H = 164 * MiB, WS_ACT = 196 * MiB, WS_F = 284 * MiB, WS_END = 348 * MiB;
constexpr size_t WS_XCH = 348 * MiB, WS_OC2 = 350 * MiB, WS_END2 = 382 * MiB;
constexpr size_t WS_OC = WS_OC2;
constexpr size_t WS_P = 196 * MiB, WS_QM = 264 * MiB, WS_KVM = 288 * MiB, WS_KPE = 320 * MiB, WS_CQN = 321 * MiB, WS_CKVN = 329 * MiB;
constexpr size_t WS_OD = 3 * MiB;
static_assert(WS_WGU1 + (size_t)NGU * DM * 2 <= WS_WD1 && WS_WD1 + (size_t)DM * FF * 2 <= WS_WIN && WS_WIN + (size_t)NIN * DM * 2 <= WS_WUQ && WS_WUQ + (size_t)NUQ * QRANK * 2 <= WS_WUKV &&
              WS_WUKV + (size_t)NUKV * QRANK * 2 <= WS_WOUT && WS_WOUT + (size_t)DM * DM * 2 <= WS_WGU2 && WS_WGU2 + (size_t)NGU * DM * 2 <= WS_WD2 && WS_WD2 + (size_t)DM * FF * 2 <= WS_H, "weights map");
static_assert(WS_H + (size_t)M * DM * 2 <= WS_ACT && WS_ACT + (size_t)M * FF * 2 <= WS_F && WS_F + (size_t)M * DM * 4 <= WS_END, "activation map");
static_assert(WS_P + (size_t)M * NIN * 2 <= WS_QM && WS_QM + (size_t)M * NUQ * 2 <= WS_KVM && WS_KVM + (size_t)M * NUKV * 2 <= WS_KPE && WS_KPE + (size_t)M * 64 * 2 <= WS_CQN &&
              WS_CQN + (size_t)M * QRANK * 2 <= WS_CKVN && WS_CKVN + (size_t)M * QRANK * 2 <= WS_END && WS_OD + (size_t)2 * M * 1024 * 4 <= WS_WIN, "mixer map");

constexpr int RING_BYTES = 131072, MISC_OFF = RING_BYTES, LDS_BYTES = 147456;
static_assert(att::LDS_BYTES <= RING_BYTES, "attention scratch fits the ring");

__device__ __forceinline__ unsigned f2bf(float f) { unsigned u = __builtin_bit_cast(unsigned, f); return (u + 0x7fffu + ((u >> 16) & 1u)) >> 16; }
__device__ __forceinline__ unsigned pk2(float lo, float hi) { return f2bf(lo) | (f2bf(hi) << 16); }
__device__ __forceinline__ float bf2f(short s) { return __uint_as_float(((unsigned)(unsigned short)s) << 16); }
__device__ __forceinline__ float wave_sum(float v) {
#pragma unroll
    for (int o = 1; o < 64; o <<= 1) v += __shfl_xor(v, o);
    return v;
}
__device__ __forceinline__ float dot4(f32x4 a) { return (a.x * a.x + a.y * a.y) + (a.z * a.z + a.w * a.w); }

template <bool SCALE = false>
__device__ __forceinline__ void transpose_item(const float* W, int K, int N, bf16* WT, int orow0, LAS float* scr, int k0, int n0, int lane, const float* gk = nullptr) {
#pragma unroll 8
    for (int i = 0; i < 32; ++i) { const int kk = 2 * i + (lane >> 5); float w = W[(size_t)(k0 + kk) * N + n0 + (lane & 31)]; if constexpr (SCALE) w *= gk[k0 + kk]; scr[kk * 33 + (lane & 31)] = w; }
    LDS_WAIT(); asm volatile("" ::: "memory");
    const int c = lane & 7;
#pragma unroll
    for (int j = 0; j < 4; ++j) { const int n = (lane >> 3) + 8 * j; const LAS float* s = scr + (8 * c) * 33 + n;
        v4u o; o.x = pk2(s[0 * 33], s[1 * 33]); o.y = pk2(s[2 * 33], s[3 * 33]); o.z = pk2(s[4 * 33], s[5 * 33]); o.w = pk2(s[6 * 33], s[7 * 33]);
        *(v4u*)(WT + (size_t)(orow0 + n) * K + k0 + 8 * c) = o; }
    LDS_WAIT(); asm volatile("" ::: "memory");
}
__device__ __forceinline__ int map_row(int map, int n0) {
    if (map == 0 || map == 4) return n0;
    if (map == 1) return (n0 >> 7) * 256 + (n0 & 127);
    if (map == 2) return (n0 >> 7) * 256 + 128 + (n0 & 127);
    if (n0 < 1024) return n0;
    if (n0 < 1088) return n0 == 1024 ? 4096 : 4096 + 128;
    if (n0 >= 3136) return n0 - 64;
    const int rel = n0 - 1088, h = (rel >> 8) & 3, w = rel & 255, c = w >> 7, e = w & 127;
    return 1024 + (rel >> 10) * 1024 + h * 256 + (e < 64 ? c * 64 + e : 128 + c * 64 + (e - 64));
}
template <bool SCALE = false>
__device__ __forceinline__ void transpose_mat(const float* W, int K, int N, bf16* WT, int map, LAS float* scr, int item, int lane, const float* gk = nullptr) {
    const int nblk = N / 32, kb = item / nblk, nb = item - kb * nblk;
    transpose_item<SCALE>(W, K, N, WT, map_row(map, nb * 32), scr, kb * 64, nb * 32, lane, gk);
}
struct CvtDesc { const float* W; bf16* WT; const float* gk; int K, N, map, item; };
__device__ __forceinline__ void cvt_load(const CvtDesc& d, int lane, float (&v)[32], f32x4& g0, f32x4& g1) {
    const int nblk = d.N >> 5, kb = d.item / nblk, nb = d.item - kb * nblk, k0 = kb * 64, n0 = nb * 32;
    const float* src = d.W + (size_t)(k0 + (lane >> 5)) * d.N + n0 + (lane & 31); const size_t step = (size_t)2 * d.N;
#pragma unroll
    for (int i = 0; i < 32; ++i) v[i] = src[i * step];
    if (d.gk) { const float* gp = d.gk + k0 + 8 * (lane >> 3); g0 = *(const f32x4*)gp; g1 = *(const f32x4*)(gp + 4); } else { g0 = (f32x4){1.f, 1.f, 1.f, 1.f}; g1 = g0; }
}
__device__ __forceinline__ void cvt_finish(const CvtDesc& d, int lane, const float (&v)[32], f32x4 g0, f32x4 g1, LAS float* scr) {
    const int nblk = d.N >> 5, kb = d.item / nblk, nb = d.item - kb * nblk, k0 = kb * 64, n0 = nb * 32, orow0 = map_row(d.map, n0);
    const float os = d.map == 4 ? 0.07216878364870322f * 1.4426950408889634f : (d.map == 3 && n0 >= 1088 && n0 < 2112) ? 0.08838834764831845f * 1.4426950408889634f : 1.0f;
    g0 = g0 * os; g1 = g1 * os;
#pragma unroll
    for (int i = 0; i < 32; ++i) scr[(2 * i + (lane >> 5)) * 33 + (lane & 31)] = v[i];
    LDS_WAIT(); asm volatile("" ::: "memory");
    const int c = lane >> 3;
#pragma unroll
    for (int j = 0; j < 4; ++j) { const int n = (lane & 7) + 8 * j; const LAS float* q = scr + (8 * c) * 33 + n;
        v4u o; o.x = pk2(q[0 * 33] * g0.x, q[1 * 33] * g0.y); o.y = pk2(q[2 * 33] * g0.z, q[3 * 33] * g0.w); o.z = pk2(q[4 * 33] * g1.x, q[5 * 33] * g1.y); o.w = pk2(q[6 * 33] * g1.z, q[7 * 33] * g1.w);
        *(v4u*)(d.WT + (size_t)(orow0 + n) * d.K + k0 + 8 * c) = o; }
    LDS_WAIT(); asm volatile("" ::: "memory");
}
#define CVT_SET(d, W_, WT_, K_, N_, map_, gk_, item_) do { (d).W = (W_); (d).WT = (WT_); (d).K = (K_); (d).N = (N_); (d).map = (map_); (d).gk = (gk_); (d).item = (item_); } while (0)
#define CVT_RUN(first, stride, total, DESC) do { int it_ = (first); CvtDesc da_, db_; float va_[32], vb_[32]; f32x4 ga0_, ga1_, gb0_ = {0.f, 0.f, 0.f, 0.f}, gb1_ = gb0_; \
        _Pragma("unroll") for (int i_ = 0; i_ < 32; ++i_) vb_[i_] = 0.f; \
        bool have_ = it_ < (total); if (have_) { DESC(it_, da_); db_ = da_; cvt_load(da_, lane, va_, ga0_, ga1_); } \
        while (have_) { const int it2_ = it_ + (stride); const bool have2_ = it2_ < (total); \
            if (have2_) { DESC(it2_, db_); cvt_load(db_, lane, vb_, gb0_, gb1_); } \
            cvt_finish(da_, lane, va_, ga0_, ga1_, scr); \
            da_ = db_; _Pragma("unroll") for (int i_ = 0; i_ < 32; ++i_) va_[i_] = vb_[i_]; ga0_ = gb0_; ga1_ = gb1_; it_ = it2_; have_ = have2_; } } while (0)

__device__ __forceinline__ void sincos_acc(float angf, float& c, float& s) {
    const double x = (double)angf; const double n = __builtin_rint(x * 0.15915494309189535);
    double r = __builtin_fma(-n, 6.283185307179586, x); r = __builtin_fma(-n, 2.4492935982947064e-16, r);
    const double r2 = r * r; double ts = 1.0, tc = 1.0, ss = 1.0, cc = 1.0;
#pragma unroll
    for (int k = 1; k <= 15; ++k) { tc *= -r2 * (1.0 / (double)((2 * k - 1) * (2 * k))); cc += tc; ts *= -r2 * (1.0 / (double)((2 * k) * (2 * k + 1))); ss += ts; }
    s = (float)(r * ss); c = (float)cc;
}
__device__ __forceinline__ float inv_freq_acc(int i2, int d) {
    const double y = -(double)i2 * (d == 64 ? 1.0 / 64.0 : 1.0 / 128.0) * 9.210340371976184; const double z = y * 0.0625; double t = 1.0, e = 1.0;
#pragma unroll
    for (int k = 1; k <= 16; ++k) { t *= z * (1.0 / (double)k); e += t; }
    e *= e; e *= e; e *= e; e *= e; return (float)e;
}

#define RLX_AGENT __ATOMIC_RELAXED, __HIP_MEMORY_SCOPE_AGENT
#define XB_TMO      128
#define XB_XCNT(j)  (256  + 64 * (j))
#define XB_XSUB(j)  (1280 + 64 * (j))
#define XB_XGEN(j)  (2304 + 64 * (j))
#define XB_TOP      3328
#define XB_TOPGEN   3392
#define XCD_BAR_WORDS 3456
#define XB_SPIN_CAP (1u << 18)

__device__ __forceinline__ unsigned xb_ld(unsigned* p)              { return __hip_atomic_load(p, __ATOMIC_RELAXED, __HIP_MEMORY_SCOPE_AGENT); }
__device__ __forceinline__ unsigned xb_add(unsigned* p, unsigned v) { return __hip_atomic_fetch_add(p, v, __ATOMIC_RELAXED, __HIP_MEMORY_SCOPE_AGENT); }
__device__ __forceinline__ unsigned xb_xcc_id() { return (unsigned)__builtin_amdgcn_s_getreg((3 << 11) | 20) & 0xFu; }
#define XB_SPIN(cond, bar) do { unsigned _sp = 0; while (cond) { __builtin_amdgcn_s_sleep(1); \
    if ((++_sp & 255u) == 0u) { if (xb_ld(&(bar)[XB_TMO])) break; if (_sp > XB_SPIN_CAP) { atomicAdd(&(bar)[XB_TMO], 1u); break; } } } } while (0)

struct XcdBarrier {
    unsigned* bar; unsigned x;
    volatile LAS unsigned* st;
};

__device__ __forceinline__ XcdBarrier xcd_barrier_post(unsigned* bar, volatile LAS unsigned* st) {
    XcdBarrier b; b.bar = bar; b.x = xb_xcc_id(); b.st = st;
    if (threadIdx.x == 0) (void)xb_add(&bar[XB_XCNT(b.x)], 1u);
    return b;
}
__device__ __forceinline__ void xcd_barrier_complete(unsigned* bar, unsigned x, unsigned& nloc, unsigned& nx) {
    const unsigned G = gridDim.x * gridDim.y * gridDim.z;
    unsigned sum, cnt, mine, sp = 0u;
    for (;;) {
        sum = 0u; cnt = 0u; mine = 0u;
#pragma unroll
        for (unsigned j = 0; j < 16; ++j) { const unsigned c = xb_ld(&bar[XB_XCNT(j)]); sum += c; cnt += (c > 0u) ? 1u : 0u; mine = (j == x) ? c : mine; }
        if (sum == G) break;
        __builtin_amdgcn_s_sleep(1);
        if ((++sp & 255u) == 0u) { if (xb_ld(&bar[XB_TMO])) break; if (sp > XB_SPIN_CAP) { atomicAdd(&bar[XB_TMO], 1u); break; } }
    }
    nloc = mine > 0u ? mine : 1u; nx = cnt > 0u ? cnt : 1u;
}

__device__ __forceinline__ void xcd_barrier(const XcdBarrier& b) {
    asm volatile("s_waitcnt vmcnt(0)" ::: "memory");
    __syncthreads();
    if (threadIdx.x == 0) {
        unsigned* bar = b.bar;
        __builtin_amdgcn_s_waitcnt(0);
        unsigned nloc = b.st[0], nx = b.st[1];
        if (nloc == 0u) { xcd_barrier_complete(bar, b.x, nloc, nx); b.st[0] = nloc; b.st[1] = nx; }
        const unsigned old = xb_add(&bar[XB_XSUB(b.x)], 1u);
        const unsigned gen = old / nloc;
        if (old + 1u == (gen + 1u) * nloc) {
            __builtin_amdgcn_fence(__ATOMIC_RELEASE, "agent");
            asm volatile("s_waitcnt vmcnt(0)" ::: "memory");
            const unsigned og = xb_add(&bar[XB_TOP], 1u);
            const unsigned tg = og / nx;
            if (og + 1u == (tg + 1u) * nx) xb_add(&bar[XB_TOPGEN], 1u);
            else XB_SPIN(xb_ld(&bar[XB_TOPGEN]) == tg, bar);
            __builtin_amdgcn_fence(__ATOMIC_ACQUIRE, "agent");
            xb_add(&bar[XB_XGEN(b.x)], 1u);
            asm volatile("s_waitcnt vmcnt(0)" ::: "memory");
        } else {
            XB_SPIN(xb_ld(&bar[XB_XGEN(b.x)]) == gen, bar);
            __builtin_amdgcn_fence(__ATOMIC_ACQUIRE, "agent");
            asm volatile("s_waitcnt vmcnt(0)" ::: "memory");
        }
    }
    __syncthreads();
}

constexpr int CW_BAR = 4096;
constexpr size_t CTL_ZERO_BYTES = 262144;
constexpr int CW_RSS = 32768;
constexpr int CW_CNT = 8192;
struct Args { const float* in[24]; float* out; unsigned char* ws; int ph_lo, ph_hi; };

__global__ void __launch_bounds__(NTHR, 2) mk_fwd(Args args) {
    __builtin_assume(__builtin_amdgcn_workitem_id_y() == 0); __builtin_assume(__builtin_amdgcn_workitem_id_z() == 0);
    extern __shared__ __attribute__((aligned(16))) unsigned char lds[];
    cg::grid_group grid = cg::this_grid();
    LAS unsigned char* ldsl = (LAS unsigned char*)lds;
    const int tid = threadIdx.x, lane = tid & 63, wave = __builtin_amdgcn_readfirstlane(tid >> 6);
    const int G = gridDim.x, bx = blockIdx.x;
    const int vcu = (G % 8 == 0) ? (bx % 8) * (G / 8) + bx / 8 : bx;
    const int gw = vcu * NWAVES + wave, NGW = G * NWAVES;
    unsigned char* ws = args.ws;
    const float* x = args.in[0]; float* out = args.out;
    unsigned* ctl = (unsigned*)(ws + WS_CTL);
    float* cs64 = (float*)(ws + WS_CS64); float* cs128 = (float*)(ws + WS_CS128);
    bf16* Wgu1 = (bf16*)(ws + WS_WGU1); bf16* Wd1 = (bf16*)(ws + WS_WD1); bf16* Win = (bf16*)(ws + WS_WIN); bf16* Wuq = (bf16*)(ws + WS_WUQ); bf16* Wukv = (bf16*)(ws + WS_WUKV);
    bf16* Wout = (bf16*)(ws + WS_WOUT); bf16* Wgu2 = (bf16*)(ws + WS_WGU2); bf16* Wd2 = (bf16*)(ws + WS_WD2);
    bf16* H = (bf16*)(ws + WS_H); bf16* ACT = (bf16*)(ws + WS_ACT); float* F = (float*)(ws + WS_F); bf16* OC = (bf16*)(ws + WS_OC);
    bf16* P = (bf16*)(ws + WS_P); bf16* QM = (bf16*)(ws + WS_QM); bf16* KVM = (bf16*)(ws + WS_KVM); bf16* KPE = (bf16*)(ws + WS_KPE); bf16* CQN = (bf16*)(ws + WS_CQN); bf16* CKVN = (bf16*)(ws + WS_CKVN);
    float* OD = (float*)(ws + WS_OD);
    const int lo = args.ph_lo, hi = args.ph_hi;
    volatile LAS unsigned* MISC = (volatile LAS unsigned*)(ldsl + MISC_OFF);
    if (tid < 32) MISC[tid] = 0u;
    __syncthreads();
    const XcdBarrier bar = xcd_barrier_post(ctl + CW_BAR, MISC + 8);
    if (lo > 1000) grid.sync();
#ifndef PH_MASK
#define PH_MASK 0x3fff
#endif
#define IN(k) ((((PH_MASK) >> (k)) & 1) && lo <= (k) && (k) < hi)
#ifndef PROBE_DUP
#define PROBE_DUP -1
#endif
#define REP(k) for (int rep_ = 0; rep_ < ((k) == PROBE_DUP ? 2 : 1); ++rep_)
#define SEAM(k) do { if (IN(k) && IN((k) + 1)) xcd_barrier(bar); } while (0)

    if (IN(0)) REP(0) {
        if (bx == 0 && tid == 0) __hip_atomic_store(ctl, 0u, __ATOMIC_RELAXED, __HIP_MEMORY_SCOPE_AGENT);
        LAS float* scr = (LAS float*)(ldsl + wave * 16384);
        constexpr int I_GU = (DM / 64) * (FF / 32), I_DN = (FF / 64) * (DM / 32);
        constexpr int NITEMS = 2 * I_GU;
#define DESC_P0(r_, d_) do { if ((r_) < I_GU) CVT_SET(d_, args.in[2], Wgu1, DM, FF, 1, (const float*)nullptr, (r_)); else CVT_SET(d_, args.in[3], Wgu1, DM, FF, 2, (const float*)nullptr, (r_) - I_GU); } while (0)
        CVT_RUN(gw, NGW, NITEMS, DESC_P0);
        { const int gt0 = vcu * NTHR + tid, NGT0 = G * NTHR; v4u z0 = {0u, 0u, 0u, 0u};
          for (int i = gt0; i < 5 * M * 8 / 4; i += NGT0) *((v4u*)(ws + WS_XCH) + i) = z0; }
        {
            const int gt = vcu * NTHR + tid, NGT = G * NTHR; v4u z = {0u, 0u, 0u, 0u};
            for (int i = gt; i < 192 * DM / 8; i += NGT) { const int half = i / (96 * DM / 8), j = i - half * (96 * DM / 8); *((v4u*)(Win + (size_t)(half ? 4256 : 4128) * DM) + j) = z; }
            for (int e = gt; e < SEQ * 32; e += NGT) { const int pos = e >> 5, i = e & 31; float c, s; sincos_acc((float)pos * inv_freq_acc(2 * i, 64), c, s); cs64[2 * e] = c; cs64[2 * e + 1] = s; }
            for (int e = gt; e < SEQ * 64; e += NGT) { const int pos = e >> 6, i = e & 63; float c, s; sincos_acc((float)pos * inv_freq_acc(2 * i, 128), c, s); cs128[2 * e] = c; cs128[2 * e + 1] = s; }
        }
        const f32x4* g4 = (const f32x4*)args.in[1] + lane;
        for (int m = gw; m < M; m += NGW) {
            const f32x4* xr = (const f32x4*)(x + (size_t)m * DM) + lane; f32x4 v[8]; float ss = 0.f;
#pragma unroll
            for (int j = 0; j < 8; ++j) { v[j] = xr[64 * j]; ss += dot4(v[j]); }
            const float rstd = 1.0f / sqrtf(wave_sum(ss) * (1.0f / DM) + EPS);
            v2u* o8 = (v2u*)(H + (size_t)m * DM) + lane;
#pragma unroll
            for (int j = 0; j < 8; ++j) { const f32x4 g = g4[64 * j]; const f32x4 y = v[j] * rstd * g; v2u w; w.x = pk2(y.x, y.y); w.y = pk2(y.z, y.w); o8[64 * j] = w; }
        }
    }
    SEAM(0);
#define GEMM_PHASE(EPI, Aptr, Bptr, N_, K_, ...) GEMM_PHASE_G(G, EPI, Aptr, Bptr, N_, K_, __VA_ARGS__)
#define GEMM_PHASE_G(GE, EPI, Aptr, Bptr, N_, K_, ...) do { pg8::Gemm g{Aptr, Bptr, M, N_, K_}; pg8::StaticOrder S; S.init(M, N_, (GE), bx); pg8::EPI E{__VA_ARGS__}; \
        pg8::gemm_phase<pg8::EPI, pg8::StaticOrder, true, true>(ldsl, g, S, E); } while (0)
#define NORM_PHASE(base, gpost, coef, gnext) do { \
        const f32x4* gp4 = (const f32x4*)(gpost) + lane; const f32x4* gn4 = (const f32x4*)(gnext) + lane; \
        for (int m = gw; m < M; m += NGW) { \
            const f32x4* fr = (const f32x4*)(F + (size_t)m * DM) + lane; const f32x4* br = (const f32x4*)((base) + (size_t)m * DM) + lane; f32x4 v[8]; float ss = 0.f; \
            _Pragma("unroll") for (int j = 0; j < 8; ++j) { v[j] = fr[64 * j]; ss += dot4(v[j]); } \
            const float rstd = (coef) / sqrtf(wave_sum(ss) * (1.0f / DM) + EPS); float s2 = 0.f; \
            f32x4* xo = (f32x4*)(out + (size_t)m * DM) + lane; \
            _Pragma("unroll") for (int j = 0; j < 8; ++j) { v[j] = br[64 * j] + v[j] * rstd * gp4[64 * j]; s2 += dot4(v[j]); xo[64 * j] = v[j]; } \
            if ((gnext) != nullptr) { const float r2 = 1.0f / sqrtf(wave_sum(s2) * (1.0f / DM) + EPS); v2u* o8 = (v2u*)(H + (size_t)m * DM) + lane; \
                _Pragma("unroll") for (int j = 0; j < 8; ++j) { const f32x4 y = v[j] * r2 * gn4[64 * j]; v2u w; w.x = pk2(y.x, y.y); w.y = pk2(y.z, y.w); o8[64 * j] = w; } } \
        } } while (0)

    constexpr int GC1 = 235, GC4 = 182;
    if (IN(1)) {
        constexpr int I_DN = (FF / 64) * (DM / 32), I_IN = (DM / 64) * (4160 / 32), I_UQ = (QRANK / 64) * (NUQ / 32), I_UKV = (QRANK / 64) * (NUKV / 32), I_OUT = (DM / 64) * (DM / 32);
#define DESC_P1(r_, d_) do { if ((r_) < I_DN) CVT_SET(d_, args.in[4], Wd1, FF, DM, 0, (const float*)nullptr, (r_)); else if ((r_) < I_DN + I_IN) CVT_SET(d_, args.in[7], Win, DM, 4160, 3, args.in[6], (r_) - I_DN); \
            else if ((r_) < I_DN + I_IN + I_UQ) CVT_SET(d_, args.in[9], Wuq, QRANK, NUQ, 4, args.in[8], (r_) - I_DN - I_IN); \
            else if ((r_) < I_DN + I_IN + I_UQ + I_UKV) CVT_SET(d_, args.in[11], Wukv, QRANK, NUKV, 0, args.in[10], (r_) - I_DN - I_IN - I_UQ); else CVT_SET(d_, args.in[17], Wout, DM, DM, 0, (const float*)nullptr, (r_) - I_DN - I_IN - I_UQ - I_UKV); } while (0)
        LAS float* scr = (LAS float*)(ldsl + wave * 16384);
        if (G == 256) {
            if (bx < GC1) GEMM_PHASE_G(GC1, EpiSwiGLU, H, Wgu1, NGU, DM, ACT, FF, nullptr);
            else CVT_RUN((bx - GC1) * NWAVES + wave, (256 - GC1) * NWAVES, I_DN + I_IN + I_UQ + I_UKV + I_OUT, DESC_P1);
        } else { GEMM_PHASE(EpiSwiGLU, H, Wgu1, NGU, DM, ACT, FF, nullptr); CVT_RUN(gw, NGW, I_DN + I_IN + I_UQ + I_UKV + I_OUT, DESC_P1); }
    }
    SEAM(1);
#define XSLOT(b) ((float*)(ws + WS_XCH) + (size_t)(b) * M * 8)
#define XCNT(b) (ctl + CW_CNT + (b) * 2048)
#define GEMM_FUSED(EPI, Aptr, Bptr, N_, K_, ...) do { pg8::Gemm g{Aptr, Bptr, M, N_, K_}; pg8::StaticOrder S; S.init(M, N_, G, bx); pg8::EPI E{__VA_ARGS__}; \
        pg8::gemm_phase<pg8::EPI, pg8::StaticOrder, false, true>(ldsl, g, S, E); } while (0)
    if (IN(2)) REP(2) GEMM_FUSED(EpiResA, ACT, Wd1, DM, FF, x, H, DM, args.in[5], 0.5f, (float*)(ctl + CW_RSS), pg8::PanelRms{XSLOT(0), XCNT(0), 8, 1.0f / DM, EPS});
    SEAM(2);

    if (IN(4)) {
        constexpr int I_GU = (DM / 64) * (FF / 32);
#define DESC_P4(r_, d_) do { if ((r_) < I_GU) CVT_SET(d_, args.in[20], Wgu2, DM, FF, 1, args.in[19], (r_)); else CVT_SET(d_, args.in[21], Wgu2, DM, FF, 2, args.in[19], (r_) - I_GU); } while (0)
        LAS float* scr = (LAS float*)(ldsl + wave * 16384);
        if (G == 256) {
            if (bx < GC4) GEMM_PHASE_G(GC4, EpiBf16R, H, Win, NIN, DM, P, NIN, (const float*)(ctl + CW_RSS), (float*)(ctl + CW_RSS + 16384), cs128, cs64, KPE);
            else CVT_RUN((bx - GC4) * NWAVES + wave, (256 - GC4) * NWAVES, 2 * I_GU, DESC_P4);
        } else { GEMM_PHASE(EpiBf16R, H, Win, NIN, DM, P, NIN, (const float*)(ctl + CW_RSS), (float*)(ctl + CW_RSS + 16384), cs128, cs64, KPE); CVT_RUN(gw, NGW, 2 * I_GU, DESC_P4); }
    }
    SEAM(4);
    if (IN(6)) REP(6) {
        LAS float* SROW = (LAS float*)(ldsl + MISC_OFF + 256);
#pragma unroll 1
        for (int which = 0; which < 2; ++which) {
            const int N_ = which == 0 ? NUKV : NUQ; const bf16* Ap = P + (which == 0 ? 512 : 0);
            pg8::StaticOrder S; S.init(M, N_, G, bx); pg8::Unit u;
            if (S.next(0, u)) {
                if (lane < 32) { const float v = ((const float*)(ctl + CW_RSS + 16384))[(which == 0 ? 8192 : 0) + u.pm * 256 + wave * 32 + lane]; SROW[wave * 32 + lane] = 1.0f / sqrtf(v * (1.0f / QRANK) + EPS); }
            }
            __syncthreads();
            { pg8::Gemm g{Ap, which == 0 ? Wukv : Wuq, M, N_, QRANK, NIN}; pg8::EpiBf16Rs E{which == 0 ? KVM : QM, N_, SROW};
              pg8::gemm_phase<pg8::EpiBf16Rs, pg8::StaticOrder, true, true>(ldsl, g, S, E); }
            __syncthreads();
        }
        asm volatile("s_waitcnt vmcnt(0)" ::: "memory");
        __syncthreads();
        if (tid == 0) { __builtin_amdgcn_fence(__ATOMIC_RELEASE, "agent"); asm volatile("s_waitcnt vmcnt(0)" ::: "memory");
            (void)__hip_atomic_fetch_add(ctl + 192, 1u, __ATOMIC_RELAXED, __HIP_MEMORY_SCOPE_AGENT); }
    }
    if (IN(7)) {
        volatile LAS unsigned* misc = (volatile LAS unsigned*)(ldsl + MISC_OFF); bool p6_seen = !(IN(6));
        for (;;) {
            if (tid == 0) misc[0] = __hip_atomic_fetch_add(ctl, 1u, __ATOMIC_RELAXED, __HIP_MEMORY_SCOPE_AGENT);
            __syncthreads();
            const int u = (int)misc[0];
            __syncthreads();
            if (u >= 768) break;
            const int qb = 7 - u / 96; int r = u % 96; const int c0 = qb * 4;
            r = (r < 64) ? r + 32 : r - 64;
            if (r < 32 && !p6_seen) {
                if (tid == 0) { unsigned sp = 0; while (__hip_atomic_load(ctl + 192, __ATOMIC_RELAXED, __HIP_MEMORY_SCOPE_AGENT) < (unsigned)G) { __builtin_amdgcn_s_sleep(2); if (++sp > (1u << 22)) break; }
                    __builtin_amdgcn_fence(__ATOMIC_ACQUIRE, "agent"); asm volatile("s_waitcnt vmcnt(0)" ::: "memory"); }
                __syncthreads(); p6_seen = true; }
            if (r < 32) { const int b = r >> 3, h = r & 7; const size_t rb = (size_t)b * SEQ, rq = rb + (size_t)qb * 256;
                att::attn_unit<true, bf16, NUQ, NUKV, NUKV, DM>(QM + rq * NUQ + h * 192, KVM + rb * NUKV + h * 256, KPE + rb * 64, KVM + rb * NUKV + h * 256 + 128,
                                                               OC + rq * DM + h * 128, c0, qb * 256, cs64, (char*)lds);
            } else { r -= 32; const int b = r >> 4, h = (r >> 2) & 3, c = (r >> 1) & 1, vh = r & 1; const size_t rb = (size_t)b * SEQ, rq = rb + (size_t)qb * 256;
                att::attn_unit<false, float, NIN, NIN, NIN, 1024>(P + rq * NIN + 1024 + h * 256 + c * 128, P + rb * NIN + 2048 + h * 256 + c * 128, nullptr, P + rb * NIN + 3072 + h * 256 + vh * 128,
                                                                 OD + (size_t)c * M * 1024 + rq * 1024 + h * 256 + vh * 128, c0, qb * 256, cs64, (char*)lds);
            }
        }
    }
    SEAM(7);
    if (IN(8)) {
        const float s1 = wave_sum(args.in[12][lane] * args.in[13][lane] + args.in[12][lane + 64] * args.in[13][lane + 64]);
        const float s2 = wave_sum(args.in[14][lane] * args.in[15][lane] + args.in[14][lane + 64] * args.in[15][lane + 64]);
        const float lam = expf(s1) - expf(s2) + 0.2f;
        const f32x4 g = *((const f32x4*)args.in[16] + lane);
        {
            f32x4 av[4][4], bv[4][4];
#pragma unroll
            for (int k = 0; k < 4; ++k) { const int m = gw + k * NGW;
#pragma unroll
                for (int h = 0; h < 4; ++h) { const int mc = m < M ? m : M - 1;
                    av[k][h] = *((const f32x4*)(OD + (size_t)mc * 1024 + h * 256) + lane); bv[k][h] = *((const f32x4*)(OD + (size_t)(M + mc) * 1024 + h * 256) + lane); } }
#pragma unroll
            for (int k = 0; k < 4; ++k) { const int m = gw + k * NGW;
                if (m < M) {
#pragma unroll
                for (int h = 0; h < 4; ++h) {
                    const f32x4 d = av[k][h] - lam * bv[k][h]; const float rstd = 0.8f / sqrtf(wave_sum(dot4(d)) * (1.0f / 256.0f) + EPS);
                    const f32x4 y = d * rstd * g; v2u w; w.x = pk2(y.x, y.y); w.y = pk2(y.z, y.w);
                    *((v2u*)(OC + (size_t)m * DM + 1024 + h * 256) + lane) = w; } } }
            for (int m = gw + 4 * NGW; m < M; m += NGW) {
#pragma unroll
                for (int h = 0; h < 4; ++h) {
                    const f32x4 a = *((const f32x4*)(OD + (size_t)m * 1024 + h * 256) + lane), b = *((const f32x4*)(OD + (size_t)(M + m) * 1024 + h * 256) + lane);
                    const f32x4 d = a - lam * b; const float rstd = 0.8f / sqrtf(wave_sum(dot4(d)) * (1.0f / 256.0f) + EPS);
                    const f32x4 y = d * rstd * g; v2u w; w.x = pk2(y.x, y.y); w.y = pk2(y.z, y.w);
                    *((v2u*)(OC + (size_t)m * DM + 1024 + h * 256) + lane) = w; } }
        }
    }
    SEAM(8);
    if (IN(9)) GEMM_FUSED(EpiResB, OC, Wout, DM, DM, H, H, DM, args.in[18], 1.0f, (float*)(ctl + CW_RSS + 8192), pg8::PanelRms{XSLOT(2), XCNT(2), 8, 1.0f / DM, EPS});
    SEAM(9);

    if (IN(11)) {
        constexpr int I_DN = (FF / 64) * (DM / 32);
#define DESC_P11(r_, d_) CVT_SET(d_, args.in[22], Wd2, FF, DM, 0, (const float*)nullptr, (r_))
        LAS float* scr = (LAS float*)(ldsl + wave * 16384);
        if (G == 256) {
            if (bx < GC1) GEMM_PHASE_G(GC1, EpiSwiGLUR, H, Wgu2, NGU, DM, ACT, FF, (const float*)(ctl + CW_RSS + 8192));
            else CVT_RUN((bx - GC1) * NWAVES + wave, (256 - GC1) * NWAVES, I_DN, DESC_P11);
        } else { GEMM_PHASE(EpiSwiGLUR, H, Wgu2, NGU, DM, ACT, FF, (const float*)(ctl + CW_RSS + 8192)); CVT_RUN(gw, NGW, I_DN, DESC_P11); }
    }
    SEAM(11);
    if (IN(12)) GEMM_FUSED(EpiResC, ACT, Wd2, DM, FF, H, out, DM, args.in[23], 0.5f, (float*)nullptr, pg8::PanelRms{XSLOT(4), XCNT(4), 8, 1.0f / DM, EPS});
#undef IN
#undef SEAM
}

extern "C" void kernel_launch(void* const* d_in, const int* in_sizes, int n_in, void* d_out, int out_size, void* d_ws, size_t ws_size, hipStream_t stream) {
    static int grid = 0;
    if (grid == 0) {
        if (n_in != 24 || in_sizes[0] != M * DM || out_size != M * DM || ws_size < WS_END2) {
            fprintf(stderr, "kernel_launch: unexpected shapes: n_in %d in0 %d out %d ws %zu (need %zu)\n", n_in, n_in > 0 ? in_sizes[0] : -1, out_size, ws_size, (size_t)WS_END2); grid = -1; return; }
        int dev = 0, cus = 0, per_cu = 0;
        if (hipGetDevice(&dev) != hipSuccess || hipDeviceGetAttribute(&cus, hipDeviceAttributeMultiprocessorCount, dev) != hipSuccess) { grid = -1; return; }
        if (hipFuncSetAttribute((const void*)mk_fwd, hipFuncAttributeMaxDynamicSharedMemorySize, LDS_BYTES) != hipSuccess) { fprintf(stderr, "kernel_launch: hipFuncSetAttribute failed\n"); grid = -1; return; }
        if (hipOccupancyMaxActiveBlocksPerMultiprocessor(&per_cu, (const void*)mk_fwd, NTHR, LDS_BYTES) != hipSuccess || per_cu < 1) { fprintf(stderr, "kernel_launch: occupancy query says %d\n", per_cu); per_cu = 1; }
        (void)hipGetLastError();
        grid = cus;
    }
    if (grid < 0) return;
    if (hipMemsetAsync((char*)d_ws + WS_CTL, 0, CTL_ZERO_BYTES, stream) != hipSuccess) { fprintf(stderr, "kernel_launch: hipMemsetAsync failed\n"); return; }
    Args a{};
    for (int i = 0; i < 24; ++i) a.in[i] = (const float*)d_in[i];
    a.out = (float*)d_out; a.ws = (unsigned char*)d_ws;
#if MK_N_LAUNCHES == 1
    a.ph_lo = 0; a.ph_hi = N_PHASES;
    void* kargs[] = {&a};
    const hipError_t le = hipLaunchCooperativeKernel((const void*)mk_fwd, dim3(grid), dim3(NTHR), kargs, LDS_BYTES, stream);
    if (le != hipSuccess) fprintf(stderr, "kernel_launch: cooperative launch failed: %s (grid %d)\n", hipGetErrorName(le), grid);
#else
    for (int li = 0; li < N_PHASES; ++li) {
        a.ph_lo = li; a.ph_hi = li + 1;
        hipLaunchKernelGGL(mk_fwd, dim3(grid), dim3(NTHR), LDS_BYTES, stream, a);
        const hipError_t le = hipPeekAtLastError();
        if (le != hipSuccess) { fprintf(stderr, "kernel_launch: launch %d failed: %s\n", li, hipGetErrorName(le)); break; }
    }
#endif
}
```

```cpp
#include <hip/hip_runtime.h>
#include <hip/hip_cooperative_groups.h>
#include <cstdio>
#include <cstdint>
namespace cg = cooperative_groups;
namespace pg8 {
#define PG8_LAS __attribute__((address_space(3)))
typedef unsigned short bf16_t;
typedef short bf16x8 __attribute__((ext_vector_type(8)));
typedef float f32x4 __attribute__((ext_vector_type(4)));
typedef unsigned u32x4 __attribute__((ext_vector_type(4)));
constexpr int BM = 256, BK = 64, HALF = 128, HTB = HALF * BK * 2  , STAGE_BYTES = 8 * HTB, NXCD = 8, WGM = 8;

__host__ __device__ __forceinline__ int lds_byte(int r, int c) { const int st = (r >> 4) * 2 + (c >> 5), rr = r & 15, cc = c & 31, ob = rr * 64 + cc * 2; return st * 1024 + (ob ^ (((ob >> 9) & 1) << 5)); }
__host__ __device__ __forceinline__ void stage_rc(int b, int& R, int& C) { const int st = b / 1024, sb = b % 1024, swz = sb ^ (((sb >> 9) & 1) << 5); R = (st >> 1) * 16 + swz / 64; C = (st & 1) * 32 + (swz % 64) / 2; }
__host__ __device__ __forceinline__ int perm32(int rho) { const int n = rho >> 4, i = rho & 15; return 8 * (i >> 2) + 4 * n + (i & 3); }

struct Unit { int pm, pn; };
struct Gemm { const bf16_t* A; const bf16_t* Bt; int M, N, K; int lda; };

struct StaticOrder {
    int nM, nN, nwg, G, c;
    __host__ __device__ __forceinline__ void init(int M, int N, int G_, int c_) { nM = M / BM; nN = N / BM; nwg = nM * nN; G = G_; c = c_; }
    __host__ __device__ __forceinline__ bool next(int i, Unit& u) const {
        const long L = (long)i * G + c; if (L >= nwg) return false;
        int wgid = (int)L; { const int q = nwg / NXCD, r = nwg % NXCD, xcd = wgid % NXCD, off = wgid / NXCD; wgid = (xcd < r ? xcd * (q + 1) : r * (q + 1) + (xcd - r) * q) + off; }
        const int nig = WGM * nN, gid = wgid / nig, fm = gid * WGM, gsz = (nM - fm) < WGM ? (nM - fm) : WGM;
        u.pm = fm + ((wgid % nig) % gsz); u.pn = (wgid % nig) / gsz; return true;
    }
    __device__ __forceinline__ void a_ready(const Unit&) const {}
    __device__ __forceinline__ void done(const Unit&) const {}
};

__device__ __forceinline__ unsigned cvt_pk_bf16(float lo, float hi) { unsigned r; asm volatile("v_cvt_pk_bf16_f32 %0, %1, %2" : "=v"(r) : "v"(lo), "v"(hi)); return r; }
template <bool RS> struct EpiBf16T {
    static constexpr bool PERM = true, AFTER_DRAIN = false;
    bf16_t* O; int ldc; const float* rowss; float* latss; const float* cs128; const float* cs64; bf16_t* KPE;
    template <bool R128> __device__ __forceinline__ void rope_tile(const f32x4 (&acc)[2][2][4][2], const Unit& u, int row0, int wc, int fq) const {
        const int ih = R128 ? 32 * (wc & 1) + 8 * fq : 8 * fq;
#pragma unroll
        for (int ai = 0; ai < 2; ++ai)
#pragma unroll
            for (int m = 0; m < 4; ++m) { const int row = row0 + ai * HALF + m * 16, pos = row & 2047;
                const float sc = 1.0f / sqrtf(rowss[row] * (1.0f / 2048.0f) + 1e-6f);
                const f32x4* cs; if constexpr (R128) cs = (const f32x4*)(cs128 + ((size_t)pos * 64 + ih) * 2); else cs = (const f32x4*)(cs64 + ((size_t)pos * 32 + ih) * 2);
                u32x4 w1, w2;
#pragma unroll
                for (int n = 0; n < 2; ++n) { const f32x4 x1 = acc[ai][0][m][n] * sc, x2 = acc[ai][1][m][n] * sc, c01 = cs[2 * n], c23 = cs[2 * n + 1];
                    const unsigned a0 = cvt_pk_bf16(x1[0] * c01[0] - x2[0] * c01[1], x1[1] * c01[2] - x2[1] * c01[3]), a1 = cvt_pk_bf16(x1[2] * c23[0] - x2[2] * c23[1], x1[3] * c23[2] - x2[3] * c23[3]);
                    const unsigned b0 = cvt_pk_bf16(x2[0] * c01[0] + x1[0] * c01[1], x2[1] * c01[2] + x1[1] * c01[3]), b1 = cvt_pk_bf16(x2[2] * c23[0] + x1[2] * c23[1], x2[3] * c23[2] + x1[3] * c23[3]);
                    if (n == 0) { w1.x = a0; w1.y = a1; w2.x = b0; w2.y = b1; } else { w1.z = a0; w1.w = a1; w2.z = b0; w2.w = b1; } }
                if constexpr (R128) { bf16_t* dst = O + (size_t)row * ldc + u.pn * BM + (wc >> 1) * 128 + ih; *(u32x4*)dst = w1; *(u32x4*)(dst + 64) = w2; }
                else { bf16_t* dst = KPE + (size_t)row * 64 + ih; *(u32x4*)dst = w1; *(u32x4*)(dst + 32) = w2; } }
    }
    __device__ __forceinline__ void operator()(const f32x4 (&acc)[2][2][4][2], const Unit& u, int wr, int wc, int fr, int fq) const {
        const int row0 = u.pm * BM + wr * 64 + fr; const int col0 = u.pn * BM + wc * 32 + 8 * fq;
        if constexpr (RS) {
            if (u.pn >= 4 && u.pn < 12) { rope_tile<true>(acc, u, row0, wc, fq); return; }
            if (u.pn == 16) { if (wc == 0) rope_tile<false>(acc, u, row0, wc, fq); return; }
        }
#pragma unroll
        for (int ai = 0; ai < 2; ++ai)
#pragma unroll
            for (int m = 0; m < 4; ++m) { bf16_t* rowp = O + (size_t)(row0 + ai * HALF + m * 16) * ldc + col0;
                float sc = 1.0f; if constexpr (RS) sc = 1.0f / sqrtf(rowss[row0 + ai * HALF + m * 16] * (1.0f / 2048.0f) + 1e-6f);
                float s2 = 0.f;
#pragma unroll
                for (int bj = 0; bj < 2; ++bj) { const f32x4 v0 = acc[ai][bj][m][0] * sc, v1 = acc[ai][bj][m][1] * sc;
                    u32x4 w; w.x = cvt_pk_bf16(v0[0], v0[1]); w.y = cvt_pk_bf16(v0[2], v0[3]); w.z = cvt_pk_bf16(v1[0], v1[1]); w.w = cvt_pk_bf16(v1[2], v1[3]);
                    *(u32x4*)(rowp + bj * HALF) = w;
                    if constexpr (RS) {
#pragma unroll
                        for (int k = 0; k < 4; ++k) { const float a = __uint_as_float(w[k] << 16), b = __uint_as_float(w[k] & 0xffff0000u); s2 += a * a + b * b; } } }
                if constexpr (RS) { if (u.pn < 4) { s2 += __shfl_xor(s2, 16); s2 += __shfl_xor(s2, 32);
                    if (fq == 0) (void)__hip_atomic_fetch_add(latss + (u.pn >> 1) * 8192 + row0 + ai * HALF + m * 16, s2, __ATOMIC_RELAXED, __HIP_MEMORY_SCOPE_AGENT); } } }
    }
};
typedef EpiBf16T<false> EpiBf16; typedef EpiBf16T<true> EpiBf16R;
struct EpiBf16Rs {
    static constexpr bool PERM = true, AFTER_DRAIN = false;
    bf16_t* O; int ldc; const PG8_LAS float* S;
    __device__ __forceinline__ void operator()(const f32x4 (&acc)[2][2][4][2], const Unit& u, int wr, int wc, int fr, int fq) const {
        const int row0 = u.pm * BM + wr * 64 + fr; const int col0 = u.pn * BM + wc * 32 + 8 * fq;
#pragma unroll
        for (int ai = 0; ai < 2; ++ai)
#pragma unroll
            for (int m = 0; m < 4; ++m) { bf16_t* rowp = O + (size_t)(row0 + ai * HALF + m * 16) * ldc + col0; const float sc = S[wr * 64 + fr + ai * HALF + m * 16];
#pragma unroll
                for (int bj = 0; bj < 2; ++bj) { const f32x4 v0 = acc[ai][bj][m][0] * sc, v1 = acc[ai][bj][m][1] * sc;
                    u32x4 w; w.x = cvt_pk_bf16(v0[0], v0[1]); w.y = cvt_pk_bf16(v0[2], v0[3]); w.z = cvt_pk_bf16(v1[0], v1[1]); w.w = cvt_pk_bf16(v1[2], v1[3]);
                    *(u32x4*)(rowp + bj * HALF) = w; } }
    }
};
__device__ __forceinline__ float silu_mul(float g, float u) { return g * u * __builtin_amdgcn_rcpf(1.0f + __builtin_amdgcn_exp2f(g * -1.4426950408889634f)); }
template <bool RS> struct EpiSwiGLUT {
    static constexpr bool PERM = true, AFTER_DRAIN = false;
    bf16_t* O; int ldc; const float* rowss;
    __device__ __forceinline__ void operator()(const f32x4 (&acc)[2][2][4][2], const Unit& u, int wr, int wc, int fr, int fq) const {
        const int row0 = u.pm * BM + wr * 64 + fr; const int col0 = u.pn * HALF + wc * 32 + 8 * fq;
#pragma unroll
        for (int ai = 0; ai < 2; ++ai)
#pragma unroll
            for (int m = 0; m < 4; ++m) { bf16_t* rowp = O + (size_t)(row0 + ai * HALF + m * 16) * ldc + col0;
                float sc = 1.0f; if constexpr (RS) sc = 1.0f / sqrtf(rowss[row0 + ai * HALF + m * 16] * (1.0f / 2048.0f) + 1e-6f);
                f32x4 g0 = acc[ai][0][m][0], g1 = acc[ai][0][m][1], u0 = acc[ai][1][m][0], u1 = acc[ai][1][m][1];
                if constexpr (RS) { g0 = g0 * sc; g1 = g1 * sc; u0 = u0 * sc; u1 = u1 * sc; }
                f32x4 e0 = g0 * -1.4426950408889634f, e1 = g1 * -1.4426950408889634f;
#pragma unroll
                for (int k = 0; k < 4; ++k) { e0[k] = __builtin_amdgcn_exp2f(e0[k]); e1[k] = __builtin_amdgcn_exp2f(e1[k]); }
                e0 = e0 + 1.0f; e1 = e1 + 1.0f;
#pragma unroll
                for (int k = 0; k < 4; ++k) { e0[k] = __builtin_amdgcn_rcpf(e0[k]); e1[k] = __builtin_amdgcn_rcpf(e1[k]); }
                const f32x4 o0 = (g0 * u0) * e0, o1 = (g1 * u1) * e1;
                u32x4 w; w.x = cvt_pk_bf16(o0[0], o0[1]); w.y = cvt_pk_bf16(o0[2], o0[3]); w.z = cvt_pk_bf16(o1[0], o1[1]); w.w = cvt_pk_bf16(o1[2], o1[3]);
                *(u32x4*)rowp = w; }
    }
};
typedef EpiSwiGLUT<false> EpiSwiGLU; typedef EpiSwiGLUT<true> EpiSwiGLUR;
struct EpiF32 {
    static constexpr bool PERM = false, AFTER_DRAIN = false;
    float* O; int ldc;
    __device__ __forceinline__ void operator()(const f32x4 (&acc)[2][2][4][2], const Unit& u, int wr, int wc, int fr, int fq) const {
        const int row0 = u.pm * BM + wr * 64 + fr; const int col0 = u.pn * BM + wc * 32 + 4 * fq;
#pragma unroll
        for (int ai = 0; ai < 2; ++ai)
#pragma unroll
            for (int m = 0; m < 4; ++m) { float* rowp = O + (size_t)(row0 + ai * HALF + m * 16) * ldc + col0;
#pragma unroll
                for (int bj = 0; bj < 2; ++bj)
#pragma unroll
                    for (int n = 0; n < 2; ++n) *(f32x4*)(rowp + bj * HALF + n * 16) = acc[ai][bj][m][n]; }
    }
};

struct PanelRms {
    float* xbuf;
    unsigned* cnt;
    int ntn; float inv_n, eps;
    __device__ __forceinline__ void publish(const f32x4 (&v)[2][2][4][2], const Unit& u, int wr, int wc, int fr, int fq, PG8_LAS unsigned char* lds, int wid, int lane) const {
        PG8_LAS float* P = (PG8_LAS float*)lds;
#pragma unroll
        for (int ai = 0; ai < 2; ++ai)
#pragma unroll
            for (int m = 0; m < 4; ++m) {
                float s = 0.f;
#pragma unroll
                for (int bj = 0; bj < 2; ++bj)
#pragma unroll
                    for (int n = 0; n < 2; ++n) { const f32x4 x = v[ai][bj][m][n]; s += (x[0] * x[0] + x[1] * x[1]) + (x[2] * x[2] + x[3] * x[3]); }
                s += __shfl_xor(s, 16); s += __shfl_xor(s, 32);
                if (fq == 0) P[(ai * HALF + wr * 64 + m * 16 + fr) * 4 + wc] = s;
            }
        asm volatile("s_waitcnt lgkmcnt(0)" ::: "memory"); __builtin_amdgcn_s_barrier(); asm volatile("" ::: "memory");
        const int row = wid * 32 + (lane & 31);
        if (lane < 32) {
            const float t = (P[row * 4 + 0] + P[row * 4 + 1]) + (P[row * 4 + 2] + P[row * 4 + 3]);
            __hip_atomic_store((unsigned*)xbuf + ((size_t)(u.pm * BM + row) * 8 + u.pn), __float_as_uint(t) | 1u, __ATOMIC_RELAXED, __HIP_MEMORY_SCOPE_AGENT);
        }
    }
    __device__ __forceinline__ void collect(const Unit& u, PG8_LAS unsigned char* lds, int wid, int lane) const {
        PG8_LAS float* S = (PG8_LAS float*)(lds + 4096);
        const int row = wid * 32 + (lane & 31);
        if (lane < 32) {
            const unsigned* slot = (const unsigned*)xbuf + (size_t)(u.pm * BM + row) * 8; unsigned w[8]; unsigned sp = 0;
            for (;;) { unsigned all = 1u;
#pragma unroll
                for (int k = 0; k < 8; ++k) { w[k] = (k < ntn) ? __hip_atomic_load(slot + k, __ATOMIC_RELAXED, __HIP_MEMORY_SCOPE_AGENT) : 1u; all &= w[k]; }
                if (all & 1u) break;
                __builtin_amdgcn_s_sleep(1); if (++sp > (1u << 20)) break; }
            float t = 0.f;
#pragma unroll
            for (int k = 0; k < 8; ++k) if (k < ntn) t += __uint_as_float(w[k]);
            S[row] = 1.0f / sqrtf(t * inv_n + eps);
        }
        asm volatile("s_waitcnt lgkmcnt(0)" ::: "memory"); __builtin_amdgcn_s_barrier(); asm volatile("" ::: "memory");
    }
};
typedef unsigned u32x2v __attribute__((ext_vector_type(2)));
__device__ __forceinline__ f32x4 raw_load4(const float* p) { return *(const f32x4*)p; }
__device__ __forceinline__ u32x2v raw_load4(const bf16_t* p) { return *(const u32x2v*)p; }
__device__ __forceinline__ f32x4 raw_cvt4(f32x4 r) { return r; }
__device__ __forceinline__ f32x4 raw_cvt4(u32x2v r) { return (f32x4){__uint_as_float(r.x << 16), __uint_as_float(r.x & 0xffff0000u), __uint_as_float(r.y << 16), __uint_as_float(r.y & 0xffff0000u)}; }
template <typename TB, typename TO, bool STAT>
struct EpiRmsRes2 {
    static constexpr bool PERM = false, AFTER_DRAIN = true;
    const TB* base; TO* out; int ldc; const float* g; float coef; float* rowss; PanelRms st;
    __device__ __forceinline__ void fused(f32x4 (&acc)[2][2][4][2], const Unit& u, int wr, int wc, int fr, int fq, PG8_LAS unsigned char* lds, int wid, int lane) const {
        const PG8_LAS float* S = (const PG8_LAS float*)(lds + 4096);
        const int col0 = u.pn * BM + wc * 32 + 4 * fq;
        st.publish(acc, u, wr, wc, fr, fq, lds, wid, lane);
        decltype(raw_load4(base)) pre[4][2][2];
#pragma unroll
        for (int m = 0; m < 4; ++m) { const size_t off = (size_t)(u.pm * BM + wr * 64 + m * 16 + fr) * ldc + col0;
#pragma unroll
            for (int bj = 0; bj < 2; ++bj)
#pragma unroll
                for (int n = 0; n < 2; ++n) pre[m][bj][n] = raw_load4(base + off + bj * HALF + n * 16); }
        st.collect(u, lds, wid, lane);
        f32x4 gv[2][2];
#pragma unroll
        for (int bj = 0; bj < 2; ++bj)
#pragma unroll
            for (int n = 0; n < 2; ++n) gv[bj][n] = *(const f32x4*)(g + col0 + bj * HALF + n * 16) * coef;
#pragma unroll
        for (int ai = 0; ai < 2; ++ai)
#pragma unroll
            for (int m = 0; m < 4; ++m) { const int r = ai * HALF + wr * 64 + m * 16 + fr; const float rs = S[r]; const size_t off = (size_t)(u.pm * BM + r) * ldc + col0; float s2 = 0.f;
#pragma unroll
                for (int bj = 0; bj < 2; ++bj)
#pragma unroll
                    for (int n = 0; n < 2; ++n) { const f32x4 bs = raw_cvt4(ai == 0 ? pre[m][bj][n] : raw_load4(base + off + bj * HALF + n * 16));
                        const f32x4 y = bs + acc[ai][bj][m][n] * rs * gv[bj][n];
                        if constexpr (sizeof(TO) == 2) { u32x2v w; w.x = cvt_pk_bf16(y[0], y[1]); w.y = cvt_pk_bf16(y[2], y[3]); *(u32x2v*)(out + off + bj * HALF + n * 16) = w;
                            if constexpr (STAT) { const f32x4 yr = raw_cvt4(w); s2 += (yr[0] * yr[0] + yr[1] * yr[1]) + (yr[2] * yr[2] + yr[3] * yr[3]); } }
                        else { __builtin_nontemporal_store(y, (f32x4*)(out + off + bj * HALF + n * 16)); if constexpr (STAT) s2 += (y[0] * y[0] + y[1] * y[1]) + (y[2] * y[2] + y[3] * y[3]); } }
                if constexpr (STAT) { s2 += __shfl_xor(s2, 16); s2 += __shfl_xor(s2, 32);
                    if (fq == 0) (void)__hip_atomic_fetch_add(rowss + (u.pm * BM + r), s2, __ATOMIC_RELAXED, __HIP_MEMORY_SCOPE_AGENT); }
                if (m & 1) asm volatile("" ::: "memory"); }
    }
};
typedef EpiRmsRes2<float, bf16_t, true> EpiResA; typedef EpiRmsRes2<bf16_t, bf16_t, true> EpiResB; typedef EpiRmsRes2<bf16_t, float, false> EpiResC;

template <class Epi, class Sched, bool ALIGN_EPI = false, bool SP2 = false>
__device__ __forceinline__ void gemm_phase(PG8_LAS unsigned char* lds, const Gemm g, const Sched& S, const Epi& E) {
    int tid_ = threadIdx.x; asm volatile("" : "+v"(tid_));
    const int tid = tid_, wid = __builtin_amdgcn_readfirstlane(tid >> 6), lane = tid & 63, wr = wid >> 2, wc = wid & 3, fr = lane & 15, fq = lane >> 4;
    const int K = g.K, nt = K / BK, lda = g.lda ? g.lda : K;
    unsigned voffA[2], voffB[2];
#pragma unroll
    for (int i = 0; i < 2; ++i) { int R, C; stage_rc(tid * 16 + i * 8192, R, C); const int Rb = Epi::PERM ? ((R & ~31) + perm32(R & 31)) : R;
        voffA[i] = (unsigned)(R * lda + C) * 2u; voffB[i] = (unsigned)(Rb * K + C) * 2u; }
    const size_t kstep = (size_t)(BK * 2);
    const size_t hstep = (size_t)HALF * K * 2;
    const size_t hstepA = (size_t)HALF * lda * 2, tstepA = 2 * hstepA;
    const size_t tstep = 2 * hstep;
    const unsigned ldsw = (unsigned)wid * 1024u;
    const int aoff = lds_byte(wr * 64 + fr, fq * 8), boff = lds_byte(wc * 32 + fr, fq * 8);
#define PG8_SA(b, h) (((b) * 2 + (h)) * HTB)
#define PG8_SB(b, h) ((4 + (b) * 2 + (h)) * HTB)
#define PG8_STAGE(bufoff, gbase, voff) do { _Pragma("unroll") for (int _i = 0; _i < 2; ++_i) \
        __builtin_amdgcn_global_load_lds((const unsigned*)((const char*)(gbase) + (voff)[_i]), (PG8_LAS unsigned*)(lds + (bufoff) + ldsw + _i * 8192), 16, 0, 0); } while (0)
#define PG8_LDA(dst, b, h) do { _Pragma("unroll") for (int m = 0; m < 4; ++m) _Pragma("unroll") for (int k = 0; k < 2; ++k) dst[m][k] = *(const PG8_LAS bf16x8*)(lds + PG8_SA(b, h) + aoff + m * 2048 + k * 1024); } while (0)
#define PG8_LDB(dst, b, h) do { _Pragma("unroll") for (int n = 0; n < 2; ++n) _Pragma("unroll") for (int k = 0; k < 2; ++k) dst[n][k] = *(const PG8_LAS bf16x8*)(lds + PG8_SB(b, h) + boff + n * 2048 + k * 1024); } while (0)
#define PG8_MMA(ai, bj, At, Bt) do { __builtin_amdgcn_s_setprio(1); _Pragma("unroll") for (int m = 0; m < 4; ++m) _Pragma("unroll") for (int n = 0; n < 2; ++n) _Pragma("unroll") for (int k = 0; k < 2; ++k) \
        acc[ai][bj][m][n] = __builtin_amdgcn_mfma_f32_16x16x32_bf16(Bt[n][k], At[m][k], acc[ai][bj][m][n], 0, 0, 0); __builtin_amdgcn_s_setprio(0); } while (0)
#define PG8_WAIT_V(n) asm volatile("s_waitcnt vmcnt(" #n ")" ::: "memory")
#define PG8_WAIT_L(n) asm volatile("s_waitcnt lgkmcnt(" #n ")" ::: "memory")
#define PG8_BAR __builtin_amdgcn_s_barrier()
#define PG8_SCHED __builtin_amdgcn_sched_barrier(0)
    Unit cur, nxt; int ui = 0;
    if (!S.next(0, cur)) return;
    f32x4 acc[2][2][4][2];
#pragma unroll
    for (int a = 0; a < 2; ++a)
#pragma unroll
        for (int b = 0; b < 2; ++b)
#pragma unroll
            for (int m = 0; m < 4; ++m)
#pragma unroll
                for (int n = 0; n < 2; ++n) acc[a][b][m][n] = (f32x4){0.f, 0.f, 0.f, 0.f};
    bf16x8 At[4][2], B0[2][2], B1[2][2];
    const char* cA = (const char*)g.A + (size_t)cur.pm * tstepA; const char* cB = (const char*)g.Bt + (size_t)cur.pn * tstep;
    S.a_ready(cur);
    if constexpr (SP2) {
        PG8_STAGE(PG8_SB(0, 0), cB, voffB); PG8_STAGE(PG8_SB(0, 1), cB + hstep, voffB); PG8_STAGE(PG8_SA(0, 0), cA, voffA); PG8_STAGE(PG8_SA(0, 1), cA + hstepA, voffA);
        if (wr == 1) PG8_BAR;
        PG8_WAIT_V(2); PG8_BAR;
        PG8_STAGE(PG8_SB(1, 0), cB + kstep, voffB); PG8_STAGE(PG8_SA(1, 0), cA + kstep, voffA); PG8_STAGE(PG8_SB(1, 1), cB + hstep + kstep, voffB);
        PG8_WAIT_V(6); PG8_BAR;
    } else {
        PG8_STAGE(PG8_SB(0, 0), cB, voffB); PG8_STAGE(PG8_SA(0, 0), cA, voffA); PG8_STAGE(PG8_SB(0, 1), cB + hstep, voffB); PG8_STAGE(PG8_SA(0, 1), cA + hstepA, voffA);
        if (wr == 1) PG8_BAR;
        PG8_WAIT_V(4); PG8_BAR;
        PG8_STAGE(PG8_SB(1, 0), cB + kstep, voffB); PG8_STAGE(PG8_SA(1, 0), cA + kstep, voffA); PG8_STAGE(PG8_SB(1, 1), cB + hstep + kstep, voffB);
        PG8_WAIT_V(6); PG8_BAR;
    }
    for (;;) {
        const bool has_next = S.next(ui + 1, nxt);
        const char* nA = has_next ? (const char*)g.A + (size_t)nxt.pm * tstepA : cA; const char* nB = has_next ? (const char*)g.Bt + (size_t)nxt.pn * tstep : cB;
        for (int t = 0; t < nt; t += 2) {
            const bool last = (t == nt - 2);
            const char* a1 = cA + (size_t)(t + 1) * kstep;
            const char* a2 = last ? nA : cA + (size_t)(t + 2) * kstep; const char* b2 = last ? nB : cB + (size_t)(t + 2) * kstep;
            const char* a3 = a2 + kstep; const char* b3 = b2 + kstep;
            if (last && has_next) S.a_ready(nxt);
            if constexpr (SP2) {
            PG8_LDB(B0, 0, 0); PG8_LDB(B1, 0, 1); PG8_SCHED; PG8_LDA(At, 0, 0); PG8_STAGE(PG8_SA(1, 1), a1 + hstepA, voffA);
            PG8_WAIT_V(8); PG8_WAIT_L(0); PG8_BAR; PG8_MMA(0, 0, At, B0); PG8_MMA(0, 1, At, B1); PG8_BAR; PG8_SCHED;
            PG8_LDA(At, 0, 1); PG8_STAGE(PG8_SB(0, 0), b2, voffB); PG8_STAGE(PG8_SB(0, 1), b2 + hstep, voffB); PG8_STAGE(PG8_SA(0, 0), a2, voffA);
            PG8_WAIT_V(8); PG8_WAIT_L(0); PG8_BAR; PG8_MMA(1, 0, At, B0); PG8_MMA(1, 1, At, B1); PG8_BAR; PG8_SCHED;
            PG8_LDB(B0, 1, 0); PG8_LDB(B1, 1, 1); PG8_SCHED; PG8_LDA(At, 1, 0); PG8_STAGE(PG8_SA(0, 1), a2 + hstepA, voffA);
            PG8_WAIT_V(8); PG8_WAIT_L(0); PG8_BAR; PG8_MMA(0, 0, At, B0); PG8_MMA(0, 1, At, B1); PG8_BAR; PG8_SCHED;
            PG8_LDA(At, 1, 1); PG8_STAGE(PG8_SB(1, 0), b3, voffB); PG8_STAGE(PG8_SB(1, 1), b3 + hstep, voffB); PG8_STAGE(PG8_SA(1, 0), a3, voffA);
            PG8_WAIT_V(8); PG8_WAIT_L(0); PG8_BAR; PG8_MMA(1, 0, At, B0); PG8_MMA(1, 1, At, B1); PG8_BAR; PG8_SCHED;
            } else {
            PG8_LDB(B0, 0, 0); PG8_SCHED; PG8_LDA(At, 0, 0); PG8_STAGE(PG8_SA(1, 1), a1 + hstepA, voffA);
            PG8_WAIT_L(8); PG8_BAR; PG8_WAIT_L(0); PG8_MMA(0, 0, At, B0); PG8_BAR; PG8_SCHED;
            PG8_LDB(B1, 0, 1); PG8_STAGE(PG8_SB(0, 0), b2, voffB);
            PG8_BAR; PG8_WAIT_L(0); PG8_MMA(0, 1, At, B1); PG8_BAR;
            PG8_LDA(At, 0, 1); PG8_STAGE(PG8_SA(0, 0), a2, voffA);
            PG8_BAR; PG8_WAIT_L(0); PG8_MMA(1, 0, At, B0); PG8_BAR; PG8_SCHED;
            PG8_STAGE(PG8_SB(0, 1), b2 + hstep, voffB);
            PG8_WAIT_V(6); PG8_BAR; PG8_MMA(1, 1, At, B1); PG8_BAR;
            PG8_LDB(B0, 1, 0); PG8_SCHED; PG8_LDA(At, 1, 0); PG8_STAGE(PG8_SA(0, 1), a2 + hstepA, voffA);
            PG8_WAIT_L(8); PG8_BAR; PG8_WAIT_L(0); PG8_MMA(0, 0, At, B0); PG8_BAR; PG8_SCHED;
            PG8_LDB(B1, 1, 1); PG8_STAGE(PG8_SB(1, 0), b3, voffB);
            PG8_BAR; PG8_WAIT_L(0); PG8_MMA(0, 1, At, B1); PG8_BAR;
            PG8_LDA(At, 1, 1); PG8_STAGE(PG8_SA(1, 0), a3, voffA);
            PG8_BAR; PG8_WAIT_L(0); PG8_MMA(1, 0, At, B0); PG8_BAR; PG8_SCHED;
            PG8_STAGE(PG8_SB(1, 1), b3 + hstep, voffB);
            PG8_WAIT_V(6); PG8_BAR; PG8_MMA(1, 1, At, B1); PG8_BAR;
            }
        }
        if constexpr (ALIGN_EPI) { if (wr == 0) PG8_BAR; }
        if constexpr (!Epi::AFTER_DRAIN) { E(acc, cur, wr, wc, fr, fq); S.done(cur); }
        if (!has_next) break;
#pragma unroll
        for (int a = 0; a < 2; ++a)
#pragma unroll
            for (int b = 0; b < 2; ++b)
#pragma unroll
                for (int m = 0; m < 4; ++m)
#pragma unroll
                    for (int n = 0; n < 2; ++n) acc[a][b][m][n] = (f32x4){0.f, 0.f, 0.f, 0.f};
        cur = nxt; cA = nA; cB = nB; ++ui;
        if constexpr (ALIGN_EPI) { if (wr == 1) PG8_BAR; }
    }
    PG8_WAIT_V(0);
    if constexpr (!ALIGN_EPI) { if (wr == 0) PG8_BAR; }
    PG8_BAR;
    if constexpr (Epi::AFTER_DRAIN) { E.fused(acc, cur, wr, wc, fr, fq, lds, wid, lane); S.done(cur); }
#undef PG8_SA
#undef PG8_SB
#undef PG8_STAGE
#undef PG8_LDA
#undef PG8_LDB
#undef PG8_MMA
#undef PG8_WAIT_V
#undef PG8_WAIT_L
#undef PG8_BAR
#undef PG8_SCHED
}
}
namespace att {
typedef unsigned short bf16_t;
using bf16x8 = __attribute__((ext_vector_type(8))) short;
using s16x4  = __attribute__((ext_vector_type(4))) short;
using f32x16 = __attribute__((ext_vector_type(16))) float;
using f32x4  = __attribute__((ext_vector_type(4))) float;
using u32x4  = __attribute__((ext_vector_type(4))) unsigned;
constexpr int NW = 8, QBLK = 32, KVBLK = 64;
constexpr int SHM_V = KVBLK * 128 * 2, SHM_K = KVBLK * 128 * 2, SHM_KP = KVBLK * 64 * 2;
constexpr int OFF_V = 0, OFF_K = 2 * SHM_V, OFF_KP = OFF_K + 2 * SHM_K, OFF_WS = OFF_KP + 2 * SHM_KP, OFF_QP = OFF_WS + NW * 64 * 4, LDS_BYTES = OFF_QP + NW * 4096;
constexpr float THR = 8.f;
#define KSWZ(row, colB) ((row) * 256 + ((colB) ^ (((((row) & 7) | (((row) >> 1) & 8))) << 4)))
#define KPSWZ(row, colB) ((row) * 128 + ((colB) ^ ((((row) >> 1) & 7) << 4)))
#define SBAR() __builtin_amdgcn_sched_barrier(0)
__device__ __forceinline__ int crow(int r, int hi) { return (r & 3) + 8 * (r >> 2) + 4 * hi; }
__device__ __forceinline__ unsigned cvtpk(float lo, float hi) { unsigned r; asm volatile("v_cvt_pk_bf16_f32 %0, %1, %2" : "=v"(r) : "v"(lo), "v"(hi)); return r; }
__device__ __forceinline__ float bf2f(short s) { return __uint_as_float(((unsigned)(unsigned short)s) << 16); }

constexpr float THRL = THR * 1.4426950408889634f;
template <bool FIRST>
__device__ __forceinline__ void partialSM(f32x16& p0, f32x16& p1, float& m_reg, float& alpha) {
  float pmax = fmaxf(p0[0], p1[0]);
#pragma unroll
  for (int r = 1; r < 16; ++r) pmax = __builtin_fmaxf(__builtin_fmaxf(pmax, p0[r]), p1[r]);
  { auto rr = __builtin_amdgcn_permlane32_swap(__float_as_uint(pmax), __float_as_uint(pmax), false, false);
    pmax = fmaxf(__uint_as_float(rr[0]), __uint_as_float(rr[1])); }
  alpha = 1.f;
  if (FIRST || !__builtin_expect(__all(pmax <= THRL), 1)) {
    const float d = FIRST ? pmax : fmaxf(pmax, 0.f);
    m_reg += d; if (!FIRST) alpha = __builtin_amdgcn_exp2f(-d);
#pragma unroll
    for (int r = 0; r < 16; ++r) { p0[r] -= d; p1[r] -= d; }
  }
#pragma unroll
  for (int r = 0; r < 16; ++r) p0[r] = __builtin_amdgcn_exp2f(p0[r]);
}
__device__ __forceinline__ void finishSM(f32x16& p0, f32x16& p1, float alpha, float& l_reg, bf16x8& pa0, bf16x8& pa1, bf16x8& pa2, bf16x8& pa3) {
#pragma unroll
  for (int r = 0; r < 16; ++r) p1[r] = __builtin_amdgcn_exp2f(p1[r]);
  float ps = 0;
#pragma unroll
  for (int r = 0; r < 16; ++r) ps += p0[r];
#pragma unroll
  for (int r = 0; r < 16; ++r) ps += p1[r];
  { auto rr = __builtin_amdgcn_permlane32_swap(__float_as_uint(ps), __float_as_uint(ps), false, false);
    ps = __uint_as_float(rr[0]) + __uint_as_float(rr[1]); }
  l_reg = l_reg * alpha + ps;
#define PK4(P, BASE, OUT) do { unsigned a0 = cvtpk(P[BASE + 0], P[BASE + 1]), a1 = cvtpk(P[BASE + 2], P[BASE + 3]);   \
    unsigned b0 = cvtpk(P[BASE + 4], P[BASE + 5]), b1 = cvtpk(P[BASE + 6], P[BASE + 7]);                              \
    auto r0 = __builtin_amdgcn_permlane32_swap(a0, b0, false, false); auto r1 = __builtin_amdgcn_permlane32_swap(a1, b1, false, false); \
    u32x4 w = {r0[0], r1[0], r0[1], r1[1]}; OUT = *reinterpret_cast<bf16x8*>(&w); } while (0)
  PK4(p0, 0, pa0); PK4(p0, 8, pa1); PK4(p1, 0, pa2); PK4(p1, 8, pa3);
#undef PK4
}
template <bool MLA>
__device__ __forceinline__ void qkt(f32x16& p0, f32x16& p1, const char* Ks, const char* Kps, const char* Qps, const bf16x8* qr, int r32, int hi, float negm) {
#pragma unroll
  for (int r = 0; r < 16; ++r) { p0[r] = negm; p1[r] = negm; }
  asm volatile("" : "+v"(r32), "+v"(hi));
#pragma unroll
  for (int d0 = 0; d0 < 8; ++d0) { int cb = (d0 * 16 + hi * 8) * 2;
    bf16x8 b0 = *reinterpret_cast<const bf16x8*>(Ks + KSWZ(r32, cb));
    bf16x8 b1 = *reinterpret_cast<const bf16x8*>(Ks + KSWZ(32 + r32, cb));
    p0 = __builtin_amdgcn_mfma_f32_32x32x16_bf16(b0, qr[d0], p0, 0, 0, 0);
    p1 = __builtin_amdgcn_mfma_f32_32x32x16_bf16(b1, qr[d0], p1, 0, 0, 0); }
  if constexpr (MLA) {
    SBAR();
#pragma unroll
    for (int d0 = 0; d0 < 4; ++d0) { int cb = (d0 * 16 + hi * 8) * 2;
      bf16x8 b0 = *reinterpret_cast<const bf16x8*>(Kps + KPSWZ(r32, cb));
      bf16x8 b1 = *reinterpret_cast<const bf16x8*>(Kps + KPSWZ(32 + r32, cb));
      const bf16x8 qp = *reinterpret_cast<const bf16x8*>(Qps + KPSWZ(r32, cb));
      p0 = __builtin_amdgcn_mfma_f32_32x32x16_bf16(b0, qp, p0, 0, 0, 0);
      p1 = __builtin_amdgcn_mfma_f32_32x32x16_bf16(b1, qp, p1, 0, 0, 0); }
  }
}
__device__ __forceinline__ int v_st(int k, int c) { const int kk = (k & ~0xC) | ((k & 4) << 1) | ((k & 8) >> 1); return ((kk >> 3) * 4 + (c >> 5)) * 512 + ((kk & 7) * 32 + (c & 31)) * 2; }
__device__ __forceinline__ int v_rd_base(int lane) { return ((lane & 3) << 3) | (((lane >> 2) & 3) << 6) | (((lane >> 4) & 1) << 5) | (((lane >> 5) & 1) << 8); }
constexpr int v_rd_off(int d0, int ks, int half) { return d0 * 512 + ks * 4096 + half * 2048; }
template <int OFF> __device__ __forceinline__ s16x4 tr_read(int vb) {
  s16x4 r; asm volatile("ds_read_b64_tr_b16 %0, %1 offset:%2" : "=&v"(r) : "v"(vb), "i"(OFF) : "memory"); return r;
}
template <int D0> __device__ __forceinline__ void pv_one(f32x16& od, int vb, bf16x8 pa0, bf16x8 pa1, bf16x8 pa2, bf16x8 pa3) {
  const s16x4 l0 = tr_read<v_rd_off(D0, 0, 0)>(vb), h0 = tr_read<v_rd_off(D0, 0, 1)>(vb), l1 = tr_read<v_rd_off(D0, 1, 0)>(vb), h1 = tr_read<v_rd_off(D0, 1, 1)>(vb);
  const s16x4 l2 = tr_read<v_rd_off(D0, 2, 0)>(vb), h2 = tr_read<v_rd_off(D0, 2, 1)>(vb), l3 = tr_read<v_rd_off(D0, 3, 0)>(vb), h3 = tr_read<v_rd_off(D0, 3, 1)>(vb);
  asm volatile("s_waitcnt lgkmcnt(0)" ::: "memory"); SBAR();
#define PK(L, H) (bf16x8){L[0], L[1], L[2], L[3], H[0], H[1], H[2], H[3]}
  od = __builtin_amdgcn_mfma_f32_32x32x16_bf16(pa0, PK(l0, h0), od, 0, 0, 0);
  od = __builtin_amdgcn_mfma_f32_32x32x16_bf16(pa1, PK(l1, h1), od, 0, 0, 0);
  od = __builtin_amdgcn_mfma_f32_32x32x16_bf16(pa2, PK(l2, h2), od, 0, 0, 0);
  od = __builtin_amdgcn_mfma_f32_32x32x16_bf16(pa3, PK(l3, h3), od, 0, 0, 0);
#undef PK
}
__device__ __forceinline__ void pv_d0(f32x16* o, int vb, bf16x8 pa0, bf16x8 pa1, bf16x8 pa2, bf16x8 pa3) {
  pv_one<0>(o[0], vb, pa0, pa1, pa2, pa3); pv_one<1>(o[1], vb, pa0, pa1, pa2, pa3); pv_one<2>(o[2], vb, pa0, pa1, pa2, pa3); pv_one<3>(o[3], vb, pa0, pa1, pa2, pa3);
}
__device__ __forceinline__ void store_o(float* p, float v) { *p = v; }
__device__ __forceinline__ void store_o(bf16_t* p, float v) { unsigned u = __float_as_uint(v); *p = (bf16_t)((u + 0x7fffu + ((u >> 16) & 1u)) >> 16); }

template <bool MLA, typename TO, int LDQ, int LDK, int LDV, int LDO>
__device__ __forceinline__ void attn_unit(const bf16_t* __restrict__ Qb, const bf16_t* __restrict__ Kh, const bf16_t* __restrict__ Kpe, const bf16_t* __restrict__ Vh,
                                          TO* __restrict__ Ob, const int c0, const int pos0, const float* __restrict__ cs64, char* lds) {
  constexpr int NQ = 8;
  constexpr float SCALE = MLA ? 0.07216878364870322f : 0.08838834764831845f;
  constexpr float C = SCALE * 1.4426950408889634f, THRS = THR / SCALE;
  const int tid = threadIdx.x, wid = tid >> 6, lane = tid & 63, r32 = lane & 31, hi = lane >> 5;
  char* V_lds = lds + OFF_V; char* K_lds = lds + OFF_K; char* KP_lds = lds + OFF_KP; char* QP_lds = lds + OFF_QP + wid * 4096;
  float* ws = (float*)(lds + OFF_WS) + wid * 64; float* li_l = ws; float* al_l = ws + 32;
  float m_reg = 0.f, l_reg = 0; f32x16 o[4] = {}; bf16x8 qr[NQ];
  const int NT = c0 + 4, jmax = c0 + (wid >> 1);
  const bf16_t* Qw = Qb + (long)(wid * QBLK + r32) * LDQ + hi * 8;
#pragma unroll
  for (int d0 = 0; d0 < NQ; ++d0) qr[d0] = *reinterpret_cast<const bf16x8*>(Qw + d0 * 16);
  if constexpr (MLA) {
    const int pos = pos0 + wid * QBLK + r32;
#pragma unroll
    for (int a = 0; a < 2; ++a) {
      const f32x4* t = reinterpret_cast<const f32x4*>(cs64 + ((long)pos * 32 + 16 * a + 8 * hi) * 2);
      const bf16x8 x1 = *reinterpret_cast<const bf16x8*>(Qw + 128 + a * 16), x2 = *reinterpret_cast<const bf16x8*>(Qw + 128 + (a + 2) * 16); u32x4 w1, w2;
#pragma unroll
      for (int jj = 0; jj < 4; ++jj) { const f32x4 cs = t[jj];
        const float a0 = bf2f(x1[2 * jj]), a1 = bf2f(x1[2 * jj + 1]), b0 = bf2f(x2[2 * jj]), b1 = bf2f(x2[2 * jj + 1]);
        w1[jj] = cvtpk(a0 * cs[0] - b0 * cs[1], a1 * cs[2] - b1 * cs[3]);
        w2[jj] = cvtpk(b0 * cs[0] + a0 * cs[1], b1 * cs[2] + a1 * cs[3]); }
      *reinterpret_cast<u32x4*>(QP_lds + KPSWZ(r32, (a * 16 + hi * 8) * 2)) = w1; *reinterpret_cast<u32x4*>(QP_lds + KPSWZ(r32, ((a + 2) * 16 + hi * 8) * 2)) = w2;
    }
  }
  const int sr = tid >> 4, sc = (tid & 15) * 8, vst0 = v_st(sr, sc), vst1 = v_st(32 + sr, sc);
  const int kpr = tid >> 3, kpc = (tid & 7) * 8;
  const int vb0 = (int)(uintptr_t)V_lds + v_rd_base(lane);
  bf16x8 vs0, vs1, ks0, ks1, kp0;
#define SLOAD(k0) do { vs0 = *reinterpret_cast<const bf16x8*>(&Vh[(long)((k0) + sr) * LDV + sc]); vs1 = *reinterpret_cast<const bf16x8*>(&Vh[(long)((k0) + 32 + sr) * LDV + sc]); \
    ks0 = *reinterpret_cast<const bf16x8*>(&Kh[(long)((k0) + sr) * LDK + sc]); ks1 = *reinterpret_cast<const bf16x8*>(&Kh[(long)((k0) + 32 + sr) * LDK + sc]); \
    if constexpr (MLA) kp0 = *reinterpret_cast<const bf16x8*>(&Kpe[(long)((k0) + kpr) * 64 + kpc]); } while (0)
#define SWRITE(b) do { *(bf16x8*)(V_lds + (b) * SHM_V + vst0) = vs0; *(bf16x8*)(V_lds + (b) * SHM_V + vst1) = vs1; { int kc = sc * 2; \
    *(bf16x8*)(K_lds + (b) * SHM_K + KSWZ(sr, kc)) = ks0; *(bf16x8*)(K_lds + (b) * SHM_K + KSWZ(32 + sr, kc)) = ks1; } \
    if constexpr (MLA) *(bf16x8*)(KP_lds + (b) * SHM_KP + KPSWZ(kpr, kpc * 2)) = kp0; } while (0)
#define SWAIT() asm volatile("s_waitcnt vmcnt(0)" ::: "memory")
#define RESC(a) do { if (__any((a) < 1.f)) { if (hi == 0) al_l[r32] = (a); asm volatile("s_waitcnt lgkmcnt(0)" ::: "memory"); \
    _Pragma("unroll") for (int d = 0; d < 4; ++d) _Pragma("unroll") for (int r = 0; r < 16; ++r) o[d][r] *= al_l[crow(r, hi)]; } } while (0)
#define MASKF(P0, P1) do { _Pragma("unroll") for (int r = 0; r < 16; ++r) { P0[r] = -1e30f; P1[r] = -1e30f; } } while (0)
#define MASKT(P0, P1, j) do { if ((j) > jmax) { _Pragma("unroll") for (int r = 0; r < 16; ++r) { P0[r] = -1e30f; P1[r] = -1e30f; } } } while (0)
  f32x16 pA0, pA1, pB0, pB1; float mnA, mnB, alA, alB; bf16x8 pa0, pa1, pa2, pa3;
  SLOAD(0); SWAIT(); SWRITE(0); __syncthreads();
  qkt<MLA>(pA0, pA1, K_lds, KP_lds, QP_lds, qr, r32, hi, 0.f); partialSM<true>(pA0, pA1, m_reg, alA);
  SLOAD(KVBLK);
  SWAIT(); SWRITE(1); __syncthreads();
  for (int j = 1; j + 1 < NT; j += 2) {
    SBAR(); if (j <= jmax) qkt<MLA>(pB0, pB1, K_lds + SHM_K, KP_lds + SHM_KP, QP_lds, qr, r32, hi, -m_reg); else MASKF(pB0, pB1);
    finishSM(pA0, pA1, alA, l_reg, pa0, pa1, pa2, pa3); SBAR();
    SLOAD((j + 1) * KVBLK); SBAR();
    pv_d0(o, vb0, pa0, pa1, pa2, pa3); partialSM<false>(pB0, pB1, m_reg, alB);
    __syncthreads(); SWAIT(); SWRITE(0);
    RESC(alB); __syncthreads();
    SBAR(); if (j + 1 <= jmax) qkt<MLA>(pA0, pA1, K_lds, KP_lds, QP_lds, qr, r32, hi, -m_reg); else MASKF(pA0, pA1);
    finishSM(pB0, pB1, alB, l_reg, pa0, pa1, pa2, pa3); SBAR();
    SLOAD((j + 2) * KVBLK); SBAR();
    pv_d0(o, vb0 + SHM_V, pa0, pa1, pa2, pa3); partialSM<false>(pA0, pA1, m_reg, alA);
    __syncthreads(); SWAIT(); SWRITE(1);
    RESC(alA); __syncthreads();
  }
  SBAR(); if (NT - 1 <= jmax) qkt<MLA>(pB0, pB1, K_lds + SHM_K, KP_lds + SHM_KP, QP_lds, qr, r32, hi, -m_reg); else MASKF(pB0, pB1);
  finishSM(pA0, pA1, alA, l_reg, pa0, pa1, pa2, pa3); SBAR();
  pv_d0(o, vb0, pa0, pa1, pa2, pa3); partialSM<false>(pB0, pB1, m_reg, alB);
  __syncthreads(); RESC(alB);
  finishSM(pB0, pB1, alB, l_reg, pa0, pa1, pa2, pa3); SBAR();
  pv_d0(o, vb0 + SHM_V, pa0, pa1, pa2, pa3);
  if (hi == 0) li_l[r32] = l_reg; asm volatile("s_waitcnt lgkmcnt(0)" ::: "memory");
  float rli[16];
#pragma unroll
  for (int r = 0; r < 16; ++r) rli[r] = __builtin_amdgcn_rcpf(li_l[crow(r, hi)]);
  TO* Ow = Ob + (long)(wid * QBLK) * LDO;
#pragma unroll
  for (int r = 0; r < 16; ++r) { const int orow = crow(r, hi);
#pragma unroll
    for (int d0 = 0; d0 < 4; ++d0) store_o(Ow + (long)orow * LDO + d0 * 32 + r32, o[d0][r] * rli[r]); }
  __syncthreads();
#undef SLOAD
#undef SWRITE
#undef SWAIT
#undef RESC
#undef MASKT
#undef MASKF
}
#undef SBAR
}
#ifndef MK_N_LAUNCHES
#define MK_N_LAUNCHES 1
#endif
constexpr int N_PHASES = 14;
constexpr int NWAVES = 8, NTHR = NWAVES * 64;
constexpr int M = 8192, DM = 2048, FF = 5632, SEQ = 2048, NIN = 4352, NGU = 2 * FF;
constexpr int QRANK = 512, NUQ = 1536, NUKV = 2048;
constexpr float EPS = 1e-6f;
typedef unsigned short bf16;
typedef float f32x4 __attribute__((ext_vector_type(4)));
typedef short bf16x8 __attribute__((ext_vector_type(8)));
typedef unsigned v4u __attribute__((ext_vector_type(4)));
typedef unsigned v2u __attribute__((ext_vector_type(2)));
#define LAS __attribute__((address_space(3)))
#define LDS_WAIT() asm volatile("s_waitcnt lgkmcnt(0)" ::: "memory")

constexpr size_t MiB = 1u << 20;
constexpr size_t WS_CTL = 0, WS_CS64 = 1 * MiB, WS_CS128 = 1 * MiB + 512 * 1024;
constexpr size_t WS_WGU1 = 3 * MiB, WS_WD1 = 47 * MiB, WS_WIN = 69 * MiB, WS_WUQ = 86 * MiB, WS_WUKV = 88 * MiB, WS_WOUT = 90 * MiB, WS_WGU2 = 98 * MiB, WS_WD2 = 142 * MiB;
constexpr size_t WS_H = 164 * MiB, WS_ACT = 196 * MiB, WS_F = 284 * MiB, WS_END = 348 * MiB;
constexpr size_t WS_XCH = 348 * MiB, WS_OC2 = 350 * MiB, WS_END2 = 382 * MiB;
constexpr size_t WS_OC = WS_OC2;
constexpr size_t WS_P = 196 * MiB, WS_QM = 264 * MiB, WS_KVM = 288 * MiB, WS_KPE = 320 * MiB, WS_CQN = 321 * MiB, WS_CKVN = 329 * MiB;
constexpr size_t WS_OD = 3 * MiB;
static_assert(WS_WGU1 + (size_t)NGU * DM * 2 <= WS_WD1 && WS_WD1 + (size_t)DM * FF * 2 <= WS_WIN && WS_WIN + (size_t)NIN * DM * 2 <= WS_WUQ && WS_WUQ + (size_t)NUQ * QRANK * 2 <= WS_WUKV &&
              WS_WUKV + (size_t)NUKV * QRANK * 2 <= WS_WOUT && WS_WOUT + (size_t)DM * DM * 2 <= WS_WGU2 && WS_WGU2 + (size_t)NGU * DM * 2 <= WS_WD2 && WS_WD2 + (size_t)DM * FF * 2 <= WS_H, "weights map");
static_assert(WS_H + (size_t)M * DM * 2 <= WS_ACT && WS_ACT + (size_t)M * FF * 2 <= WS_F && WS_F + (size_t)M * DM * 4 <= WS_END, "activation map");
static_assert(WS_P + (size_t)M * NIN * 2 <= WS_QM && WS_QM + (size_t)M * NUQ * 2 <= WS_KVM && WS_KVM + (size_t)M * NUKV * 2 <= WS_KPE && WS_KPE + (size_t)M * 64 * 2 <= WS_CQN &&
              WS_CQN + (size_t)M * QRANK * 2 <= WS_CKVN && WS_CKVN + (size_t)M * QRANK * 2 <= WS_END && WS_OD + (size_t)2 * M * 1024 * 4 <= WS_WIN, "mixer map");

constexpr int RING_BYTES = 131072, MISC_OFF = RING_BYTES, LDS_BYTES = 147456;
static_assert(att::LDS_BYTES <= RING_BYTES, "attention scratch fits the ring");

__device__ __forceinline__ unsigned f2bf(float f) { unsigned u = __builtin_bit_cast(unsigned, f); return (u + 0x7fffu + ((u >> 16) & 1u)) >> 16; }
__device__ __forceinline__ unsigned pk2(float lo, float hi) { return f2bf(lo) | (f2bf(hi) << 16); }
__device__ __forceinline__ float bf2f(short s) { return __uint_as_float(((unsigned)(unsigned short)s) << 16); }
__device__ __forceinline__ float wave_sum(float v) {
#pragma unroll
    for (int o = 1; o < 64; o <<= 1) v += __shfl_xor(v, o);
    return v;
}
__device__ __forceinline__ float dot4(f32x4 a) { return (a.x * a.x + a.y * a.y) + (a.z * a.z + a.w * a.w); }

template <bool SCALE = false>
__device__ __forceinline__ void transpose_item(const float* W, int K, int N, bf16* WT, int orow0, LAS float* scr, int k0, int n0, int lane, const float* gk = nullptr) {
#pragma unroll 8
    for (int i = 0; i < 32; ++i) { const int kk = 2 * i + (lane >> 5); float w = W[(size_t)(k0 + kk) * N + n0 + (lane & 31)]; if constexpr (SCALE) w *= gk[k0 + kk]; scr[kk * 33 + (lane & 31)] = w; }
    LDS_WAIT(); asm volatile("" ::: "memory");
    const int c = lane & 7;
#pragma unroll
    for (int j = 0; j < 4; ++j) { const int n = (lane >> 3) + 8 * j; const LAS float* s = scr + (8 * c) * 33 + n;
        v4u o; o.x = pk2(s[0 * 33], s[1 * 33]); o.y = pk2(s[2 * 33], s[3 * 33]); o.z = pk2(s[4 * 33], s[5 * 33]); o.w = pk2(s[6 * 33], s[7 * 33]);
        *(v4u*)(WT + (size_t)(orow0 + n) * K + k0 + 8 * c) = o; }
    LDS_WAIT(); asm volatile("" ::: "memory");
}
__device__ __forceinline__ int map_row(int map, int n0) {
    if (map == 0 || map == 4) return n0;
    if (map == 1) return (n0 >> 7) * 256 + (n0 & 127);
    if (map == 2) return (n0 >> 7) * 256 + 128 + (n0 & 127);
    if (n0 < 1024) return n0;
    if (n0 < 1088) return n0 == 1024 ? 4096 : 4096 + 128;
    if (n0 >= 3136) return n0 - 64;
    const int rel = n0 - 1088, h = (rel >> 8) & 3, w = rel & 255, c = w >> 7, e = w & 127;
    return 1024 + (rel >> 10) * 1024 + h * 256 + (e < 64 ? c * 64 + e : 128 + c * 64 + (e - 64));
}
template <bool SCALE = false>
__device__ __forceinline__ void transpose_mat(const float* W, int K, int N, bf16* WT, int map, LAS float* scr, int item, int lane, const float* gk = nullptr) {
    const int nblk = N / 32, kb = item / nblk, nb = item - kb * nblk;
    transpose_item<SCALE>(W, K, N, WT, map_row(map, nb * 32), scr, kb * 64, nb * 32, lane, gk);
}
struct CvtDesc { const float* W; bf16* WT; const float* gk; int K, N, map, item; };
__device__ __forceinline__ void cvt_load(const CvtDesc& d, int lane, float (&v)[32], f32x4& g0, f32x4& g1) {
    const int nblk = d.N >> 5, kb = d.item / nblk, nb = d.item - kb * nblk, k0 = kb * 64, n0 = nb * 32;
    const float* src = d.W + (size_t)(k0 + (lane >> 5)) * d.N + n0 + (lane & 31); const size_t step = (size_t)2 * d.N;
#pragma unroll
    for (int i = 0; i < 32; ++i) v[i] = __builtin_nontemporal_load(src + i * step);
    if (d.gk) { const float* gp = d.gk + k0 + 8 * (lane & 7); g0 = *(const f32x4*)gp; g1 = *(const f32x4*)(gp + 4); } else { g0 = (f32x4){1.f, 1.f, 1.f, 1.f}; g1 = g0; }
}
__device__ __forceinline__ void cvt_finish(const CvtDesc& d, int lane, const float (&v)[32], f32x4 g0, f32x4 g1, LAS float* scr) {
    const int nblk = d.N >> 5, kb = d.item / nblk, nb = d.item - kb * nblk, k0 = kb * 64, n0 = nb * 32, orow0 = map_row(d.map, n0);
    const float os = d.map == 4 ? 0.07216878364870322f * 1.4426950408889634f : (d.map == 3 && n0 >= 1088 && n0 < 2112) ? 0.08838834764831845f * 1.4426950408889634f : 1.0f;
    g0 = g0 * os; g1 = g1 * os;
#pragma unroll
    for (int i = 0; i < 32; ++i) scr[(2 * i + (lane >> 5)) * 33 + (lane & 31)] = v[i];
    LDS_WAIT(); asm volatile("" ::: "memory");
    const int c = lane & 7;
#pragma unroll
    for (int j = 0; j < 4; ++j) { const int n = (lane >> 3) + 8 * j; const LAS float* q = scr + (8 * c) * 33 + n;
        v4u o; o.x = pk2(q[0 * 33] * g0.x, q[1 * 33] * g0.y); o.y = pk2(q[2 * 33] * g0.z, q[3 * 33] * g0.w); o.z = pk2(q[4 * 33] * g1.x, q[5 * 33] * g1.y); o.w = pk2(q[6 * 33] * g1.z, q[7 * 33] * g1.w);
        *(v4u*)(d.WT + (size_t)(orow0 + n) * d.K + k0 + 8 * c) = o; }
    LDS_WAIT(); asm volatile("" ::: "memory");
}
#define CVT_SET(d, W_, WT_, K_, N_, map_, gk_, item_) do { (d).W = (W_); (d).WT = (WT_); (d).K = (K_); (d).N = (N_); (d).map = (map_); (d).gk = (gk_); (d).item = (item_); } while (0)
#define CVT_RUN(first, stride, total, DESC) do { int it_ = (first); CvtDesc da_, db_; float va_[32], vb_[32]; f32x4 ga0_, ga1_, gb0_ = {0.f, 0.f, 0.f, 0.f}, gb1_ = gb0_; \
        _Pragma("unroll") for (int i_ = 0; i_ < 32; ++i_) vb_[i_] = 0.f; \
        bool have_ = it_ < (total); if (have_) { DESC(it_, da_); db_ = da_; cvt_load(da_, lane, va_, ga0_, ga1_); } \
        while (have_) { const int it2_ = it_ + (stride); const bool have2_ = it2_ < (total); \
            if (have2_) { DESC(it2_, db_); cvt_load(db_, lane, vb_, gb0_, gb1_); } \
            cvt_finish(da_, lane, va_, ga0_, ga1_, scr); \
            da_ = db_; _Pragma("unroll") for (int i_ = 0; i_ < 32; ++i_) va_[i_] = vb_[i_]; ga0_ = gb0_; ga1_ = gb1_; it_ = it2_; have_ = have2_; } } while (0)

__device__ __forceinline__ void sincos_acc(float angf, float& c, float& s) {
    const double x = (double)angf; const double n = __builtin_rint(x * 0.15915494309189535);
    double r = __builtin_fma(-n, 6.283185307179586, x); r = __builtin_fma(-n, 2.4492935982947064e-16, r);
    const double r2 = r * r; double ts = 1.0, tc = 1.0, ss = 1.0, cc = 1.0;
#pragma unroll
    for (int k = 1; k <= 15; ++k) { tc *= -r2 * (1.0 / (double)((2 * k - 1) * (2 * k))); cc += tc; ts *= -r2 * (1.0 / (double)((2 * k) * (2 * k + 1))); ss += ts; }
    s = (float)(r * ss); c = (float)cc;
}
__device__ __forceinline__ float inv_freq_acc(int i2, int d) {
    const double y = -(double)i2 * (d == 64 ? 1.0 / 64.0 : 1.0 / 128.0) * 9.210340371976184; const double z = y * 0.0625; double t = 1.0, e = 1.0;
#pragma unroll
    for (int k = 1; k <= 16; ++k) { t *= z * (1.0 / (double)k); e += t; }
    e *= e; e *= e; e *= e; e *= e; return (float)e;
}

#define RLX_AGENT __ATOMIC_RELAXED, __HIP_MEMORY_SCOPE_AGENT
#define XB_TMO      128
#define XB_XCNT(j)  (256  + 64 * (j))
#define XB_XSUB(j)  (1280 + 64 * (j))
#define XB_XGEN(j)  (2304 + 64 * (j))
#define XB_TOP      3328
#define XB_TOPGEN   3392
#define XCD_BAR_WORDS 3456
#define XB_SPIN_CAP (1u << 18)

__device__ __forceinline__ unsigned xb_ld(unsigned* p)              { return __hip_atomic_load(p, __ATOMIC_RELAXED, __HIP_MEMORY_SCOPE_AGENT); }
__device__ __forceinline__ unsigned xb_add(unsigned* p, unsigned v) { return __hip_atomic_fetch_add(p, v, __ATOMIC_RELAXED, __HIP_MEMORY_SCOPE_AGENT); }
__device__ __forceinline__ unsigned xb_xcc_id() { return (unsigned)__builtin_amdgcn_s_getreg((3 << 11) | 20) & 0xFu; }
#define XB_SPIN(cond, bar) do { unsigned _sp = 0; while (cond) { __builtin_amdgcn_s_sleep(1); \
    if ((++_sp & 255u) == 0u) { if (xb_ld(&(bar)[XB_TMO])) break; if (_sp > XB_SPIN_CAP) { atomicAdd(&(bar)[XB_TMO], 1u); break; } } } } while (0)

struct XcdBarrier {
    unsigned* bar; unsigned x;
    volatile LAS unsigned* st;
};

__device__ __forceinline__ XcdBarrier xcd_barrier_post(unsigned* bar, volatile LAS unsigned* st) {
    XcdBarrier b; b.bar = bar; b.x = xb_xcc_id(); b.st = st;
    if (threadIdx.x == 0) (void)xb_add(&bar[XB_XCNT(b.x)], 1u);
    return b;
}
__device__ __forceinline__ void xcd_barrier_complete(unsigned* bar, unsigned x, unsigned& nloc, unsigned& nx) {
    const unsigned G = gridDim.x * gridDim.y * gridDim.z;
    unsigned sum, cnt, mine, sp = 0u;
    for (;;) {
        sum = 0u; cnt = 0u; mine = 0u;
#pragma unroll
        for (unsigned j = 0; j < 16; ++j) { const unsigned c = xb_ld(&bar[XB_XCNT(j)]); sum += c; cnt += (c > 0u) ? 1u : 0u; mine = (j == x) ? c : mine; }
        if (sum == G) break;
        __builtin_amdgcn_s_sleep(1);
        if ((++sp & 255u) == 0u) { if (xb_ld(&bar[XB_TMO])) break; if (sp > XB_SPIN_CAP) { atomicAdd(&bar[XB_TMO], 1u); break; } }
    }
    nloc = mine > 0u ? mine : 1u; nx = cnt > 0u ? cnt : 1u;
}

__device__ __forceinline__ void xcd_barrier(const XcdBarrier& b) {
    asm volatile("s_waitcnt vmcnt(0)" ::: "memory");
    __syncthreads();
    if (threadIdx.x == 0) {
        unsigned* bar = b.bar;
        __builtin_amdgcn_s_waitcnt(0);
        unsigned nloc = b.st[0], nx = b.st[1];
        if (nloc == 0u) { xcd_barrier_complete(bar, b.x, nloc, nx); b.st[0] = nloc; b.st[1] = nx; }
        const unsigned old = xb_add(&bar[XB_XSUB(b.x)], 1u);
        const unsigned gen = old / nloc;
        if (old + 1u == (gen + 1u) * nloc) {
            __builtin_amdgcn_fence(__ATOMIC_RELEASE, "agent");
            asm volatile("s_waitcnt vmcnt(0)" ::: "memory");
            const unsigned og = xb_add(&bar[XB_TOP], 1u);
            const unsigned tg = og / nx;
            if (og + 1u == (tg + 1u) * nx) xb_add(&bar[XB_TOPGEN], 1u);
            else XB_SPIN(xb_ld(&bar[XB_TOPGEN]) == tg, bar);
            __builtin_amdgcn_fence(__ATOMIC_ACQUIRE, "agent");
            xb_add(&bar[XB_XGEN(b.x)], 1u);
            asm volatile("s_waitcnt vmcnt(0)" ::: "memory");
        } else {
            XB_SPIN(xb_ld(&bar[XB_XGEN(b.x)]) == gen, bar);
            __builtin_amdgcn_fence(__ATOMIC_ACQUIRE, "agent");
            asm volatile("s_waitcnt vmcnt(0)" ::: "memory");
        }
    }
    __syncthreads();
}

constexpr int CW_BAR = 4096;
constexpr size_t CTL_ZERO_BYTES = 262144;
constexpr int CW_RSS = 32768;
constexpr int CW_CNT = 8192;
struct Args { const float* in[24]; float* out; unsigned char* ws; int ph_lo, ph_hi; };

__global__ void __launch_bounds__(NTHR, 2) mk_fwd(Args args) {
    __builtin_assume(__builtin_amdgcn_workitem_id_y() == 0); __builtin_assume(__builtin_amdgcn_workitem_id_z() == 0);
    extern __shared__ __attribute__((aligned(16))) unsigned char lds[];
    cg::grid_group grid = cg::this_grid();
    LAS unsigned char* ldsl = (LAS unsigned char*)lds;
    const int tid = threadIdx.x, lane = tid & 63, wave = __builtin_amdgcn_readfirstlane(tid >> 6);
    const int G = gridDim.x, bx = blockIdx.x;
    const int vcu = (G % 8 == 0) ? (bx % 8) * (G / 8) + bx / 8 : bx;
    const int gw = vcu * NWAVES + wave, NGW = G * NWAVES;
    unsigned char* ws = args.ws;
    const float* x = args.in[0]; float* out = args.out;
    unsigned* ctl = (unsigned*)(ws + WS_CTL);
    float* cs64 = (float*)(ws + WS_CS64); float* cs128 = (float*)(ws + WS_CS128);
    bf16* Wgu1 = (bf16*)(ws + WS_WGU1); bf16* Wd1 = (bf16*)(ws + WS_WD1); bf16* Win = (bf16*)(ws + WS_WIN); bf16* Wuq = (bf16*)(ws + WS_WUQ); bf16* Wukv = (bf16*)(ws + WS_WUKV);
    bf16* Wout = (bf16*)(ws + WS_WOUT); bf16* Wgu2 = (bf16*)(ws + WS_WGU2); bf16* Wd2 = (bf16*)(ws + WS_WD2);
    bf16* H = (bf16*)(ws + WS_H); bf16* ACT = (bf16*)(ws + WS_ACT); float* F = (float*)(ws + WS_F); bf16* OC = (bf16*)(ws + WS_OC);
    bf16* P = (bf16*)(ws + WS_P); bf16* QM = (bf16*)(ws + WS_QM); bf16* KVM = (bf16*)(ws + WS_KVM); bf16* KPE = (bf16*)(ws + WS_KPE); bf16* CQN = (bf16*)(ws + WS_CQN); bf16* CKVN = (bf16*)(ws + WS_CKVN);
    float* OD = (float*)(ws + WS_OD);
    const int lo = args.ph_lo, hi = args.ph_hi;
    volatile LAS unsigned* MISC = (volatile LAS unsigned*)(ldsl + MISC_OFF);
    if (tid < 32) MISC[tid] = 0u;
    __syncthreads();
    const XcdBarrier bar = xcd_barrier_post(ctl + CW_BAR, MISC + 8);
    if (lo > 1000) grid.sync();
#ifndef PH_MASK
#define PH_MASK 0x3fff
#endif
#define IN(k) ((((PH_MASK) >> (k)) & 1) && lo <= (k) && (k) < hi)
#ifndef PROBE_DUP
#define PROBE_DUP -1
#endif
#define REP(k) for (int rep_ = 0; rep_ < ((k) == PROBE_DUP ? 2 : 1); ++rep_)
#define SEAM(k) do { if (IN(k) && IN((k) + 1)) xcd_barrier(bar); } while (0)

    if (IN(0)) REP(0) {
        if (bx == 0 && tid == 0) __hip_atomic_store(ctl, 0u, __ATOMIC_RELAXED, __HIP_MEMORY_SCOPE_AGENT);
        LAS float* scr = (LAS float*)(ldsl + wave * 16384);
        constexpr int I_GU = (DM / 64) * (FF / 32), I_DN = (FF / 64) * (DM / 32);
        constexpr int NITEMS = 2 * I_GU;
#define DESC_P0(r_, d_) do { if ((r_) < I_GU) CVT_SET(d_, args.in[2], Wgu1, DM, FF, 1, (const float*)nullptr, (r_)); else CVT_SET(d_, args.in[3], Wgu1, DM, FF, 2, (const float*)nullptr, (r_) - I_GU); } while (0)
        CVT_RUN(gw, NGW, NITEMS, DESC_P0);
        { const int gt0 = vcu * NTHR + tid, NGT0 = G * NTHR; v4u z0 = {0u, 0u, 0u, 0u};
          for (int i = gt0; i < 5 * M * 8 / 4; i += NGT0) *((v4u*)(ws + WS_XCH) + i) = z0; }
        {
            const int gt = vcu * NTHR + tid, NGT = G * NTHR; v4u z = {0u, 0u, 0u, 0u};
            for (int i = gt; i < 192 * DM / 8; i += NGT) { const int half = i / (96 * DM / 8), j = i - half * (96 * DM / 8); *((v4u*)(Win + (size_t)(half ? 4256 : 4128) * DM) + j) = z; }
            for (int e = gt; e < SEQ * 32; e += NGT) { const int pos = e >> 5, i = e & 31; float c, s; sincos_acc((float)pos * inv_freq_acc(2 * i, 64), c, s); cs64[2 * e] = c; cs64[2 * e + 1] = s; }
            for (int e = gt; e < SEQ * 64; e += NGT) { const int pos = e >> 6, i = e & 63; float c, s; sincos_acc((float)pos * inv_freq_acc(2 * i, 128), c, s); cs128[2 * e] = c; cs128[2 * e + 1] = s; }
        }
        const f32x4* g4 = (const f32x4*)args.in[1] + lane;
        for (int m = gw; m < M; m += NGW) {
            const f32x4* xr = (const f32x4*)(x + (size_t)m * DM) + lane; f32x4 v[8]; float ss = 0.f;
#pragma unroll
            for (int j = 0; j < 8; ++j) { v[j] = xr[64 * j]; ss += dot4(v[j]); }
            const float rstd = 1.0f / sqrtf(wave_sum(ss) * (1.0f / DM) + EPS);
            v2u* o8 = (v2u*)(H + (size_t)m * DM) + lane;
#pragma unroll
            for (int j = 0; j < 8; ++j) { const f32x4 g = g4[64 * j]; const f32x4 y = v[j] * rstd * g; v2u w; w.x = pk2(y.x, y.y); w.y = pk2(y.z, y.w); o8[64 * j] = w; }
        }
    }
    SEAM(0);
#define GEMM_PHASE(EPI, Aptr, Bptr, N_, K_, ...) GEMM_PHASE_G(G, EPI, Aptr, Bptr, N_, K_, __VA_ARGS__)
#define GEMM_PHASE_G(GE, EPI, Aptr, Bptr, N_, K_, ...) do { pg8::Gemm g{Aptr, Bptr, M, N_, K_}; pg8::StaticOrder S; S.init(M, N_, (GE), bx); pg8::EPI E{__VA_ARGS__}; \
        pg8::gemm_phase<pg8::EPI, pg8::StaticOrder, true, true>(ldsl, g, S, E); } while (0)
#define NORM_PHASE(base, gpost, coef, gnext) do { \
        const f32x4* gp4 = (const f32x4*)(gpost) + lane; const f32x4* gn4 = (const f32x4*)(gnext) + lane; \
        for (int m = gw; m < M; m += NGW) { \
            const f32x4* fr = (const f32x4*)(F + (size_t)m * DM) + lane; const f32x4* br = (const f32x4*)((base) + (size_t)m * DM) + lane; f32x4 v[8]; float ss = 0.f; \
            _Pragma("unroll") for (int j = 0; j < 8; ++j) { v[j] = fr[64 * j]; ss += dot4(v[j]); } \
            const float rstd = (coef) / sqrtf(wave_sum(ss) * (1.0f / DM) + EPS); float s2 = 0.f; \
            f32x4* xo = (f32x4*)(out + (size_t)m * DM) + lane; \
            _Pragma("unroll") for (int j = 0; j < 8; ++j) { v[j] = br[64 * j] + v[j] * rstd * gp4[64 * j]; s2 += dot4(v[j]); xo[64 * j] = v[j]; } \
            if ((gnext) != nullptr) { const float r2 = 1.0f / sqrtf(wave_sum(s2) * (1.0f / DM) + EPS); v2u* o8 = (v2u*)(H + (size_t)m * DM) + lane; \
                _Pragma("unroll") for (int j = 0; j < 8; ++j) { const f32x4 y = v[j] * r2 * gn4[64 * j]; v2u w; w.x = pk2(y.x, y.y); w.y = pk2(y.z, y.w); o8[64 * j] = w; } } \
        } } while (0)

    constexpr int GC1 = 235, GC4 = 182;
    if (IN(1)) {
        constexpr int I_DN = (FF / 64) * (DM / 32), I_IN = (DM / 64) * (4160 / 32), I_UQ = (QRANK / 64) * (NUQ / 32), I_UKV = (QRANK / 64) * (NUKV / 32), I_OUT = (DM / 64) * (DM / 32);
#define DESC_P1(r_, d_) do { if ((r_) < I_DN) CVT_SET(d_, args.in[4], Wd1, FF, DM, 0, (const float*)nullptr, (r_)); else if ((r_) < I_DN + I_IN) CVT_SET(d_, args.in[7], Win, DM, 4160, 3, args.in[6], (r_) - I_DN); \
            else if ((r_) < I_DN + I_IN + I_UQ) CVT_SET(d_, args.in[9], Wuq, QRANK, NUQ, 4, args.in[8], (r_) - I_DN - I_IN); \
            else if ((r_) < I_DN + I_IN + I_UQ + I_UKV) CVT_SET(d_, args.in[11], Wukv, QRANK, NUKV, 0, args.in[10], (r_) - I_DN - I_IN - I_UQ); else CVT_SET(d_, args.in[17], Wout, DM, DM, 0, (const float*)nullptr, (r_) - I_DN - I_IN - I_UQ - I_UKV); } while (0)
        LAS float* scr = (LAS float*)(ldsl + wave * 16384);
        if (G == 256) {
            if (bx < GC1) GEMM_PHASE_G(GC1, EpiSwiGLU, H, Wgu1, NGU, DM, ACT, FF, nullptr);
            else CVT_RUN((bx - GC1) * NWAVES + wave, (256 - GC1) * NWAVES, I_DN + I_IN + I_UQ + I_UKV + I_OUT, DESC_P1);
        } else { GEMM_PHASE(EpiSwiGLU, H, Wgu1, NGU, DM, ACT, FF, nullptr); CVT_RUN(gw, NGW, I_DN + I_IN + I_UQ + I_UKV + I_OUT, DESC_P1); }
    }
    SEAM(1);
#define XSLOT(b) ((float*)(ws + WS_XCH) + (size_t)(b) * M * 8)
#define XCNT(b) (ctl + CW_CNT + (b) * 2048)
#define GEMM_FUSED(EPI, Aptr, Bptr, N_, K_, ...) do { pg8::Gemm g{Aptr, Bptr, M, N_, K_}; pg8::StaticOrder S; S.init(M, N_, G, bx); pg8::EPI E{__VA_ARGS__}; \
        pg8::gemm_phase<pg8::EPI, pg8::StaticOrder, false, true>(ldsl, g, S, E); } while (0)
    if (IN(2)) REP(2) GEMM_FUSED(EpiResA, ACT, Wd1, DM, FF, x, H, DM, args.in[5], 0.5f, (float*)(ctl + CW_RSS), pg8::PanelRms{XSLOT(0), XCNT(0), 8, 1.0f / DM, EPS});
    SEAM(2);

    if (IN(4)) {
        constexpr int I_GU = (DM / 64) * (FF / 32);
#define DESC_P4(r_, d_) do { if ((r_) < I_GU) CVT_SET(d_, args.in[20], Wgu2, DM, FF, 1, args.in[19], (r_)); else CVT_SET(d_, args.in[21], Wgu2, DM, FF, 2, args.in[19], (r_) - I_GU); } while (0)
        LAS float* scr = (LAS float*)(ldsl + wave * 16384);
        if (G == 256) {
            if (bx < GC4) GEMM_PHASE_G(GC4, EpiBf16R, H, Win, NIN, DM, P, NIN, (const float*)(ctl + CW_RSS), (float*)(ctl + CW_RSS + 16384), cs128, cs64, KPE);
            else CVT_RUN((bx - GC4) * NWAVES + wave, (256 - GC4) * NWAVES, 2 * I_GU, DESC_P4);
        } else { GEMM_PHASE(EpiBf16R, H, Win, NIN, DM, P, NIN, (const float*)(ctl + CW_RSS), (float*)(ctl + CW_RSS + 16384), cs128, cs64, KPE); CVT_RUN(gw, NGW, 2 * I_GU, DESC_P4); }
    }
    SEAM(4);
    if (IN(6)) REP(6) {
        LAS float* SROW = (LAS float*)(ldsl + MISC_OFF + 256);
#pragma unroll 1
        for (int which = 0; which < 2; ++which) {
            const int N_ = which == 0 ? NUKV : NUQ; const bf16* Ap = P + (which == 0 ? 512 : 0);
            pg8::StaticOrder S; S.init(M, N_, G, bx); pg8::Unit u;
            if (S.next(0, u)) {
                if (lane < 32) { const float v = ((const float*)(ctl + CW_RSS + 16384))[(which == 0 ? 8192 : 0) + u.pm * 256 + wave * 32 + lane]; SROW[wave * 32 + lane] = 1.0f / sqrtf(v * (1.0f / QRANK) + EPS); }
            }
            __syncthreads();
            { pg8::Gemm g{Ap, which == 0 ? Wukv : Wuq, M, N_, QRANK, NIN}; pg8::EpiBf16Rs E{which == 0 ? KVM : QM, N_, SROW};
              pg8::gemm_phase<pg8::EpiBf16Rs, pg8::StaticOrder, true, true>(ldsl, g, S, E); }
            __syncthreads();
        }
        asm volatile("s_waitcnt vmcnt(0)" ::: "memory");
        __syncthreads();
        if (tid == 0) { __builtin_amdgcn_fence(__ATOMIC_RELEASE, "agent"); asm volatile("s_waitcnt vmcnt(0)" ::: "memory");
            (void)__hip_atomic_fetch_add(ctl + 192, 1u, __ATOMIC_RELAXED, __HIP_MEMORY_SCOPE_AGENT); }
    }
    if (IN(7)) {
        volatile LAS unsigned* misc = (volatile LAS unsigned*)(ldsl + MISC_OFF); bool p6_seen = !(IN(6));
        for (;;) {
            if (tid == 0) misc[0] = __hip_atomic_fetch_add(ctl, 1u, __ATOMIC_RELAXED, __HIP_MEMORY_SCOPE_AGENT);
            __syncthreads();
            const int u = (int)misc[0];
            __syncthreads();
            if (u >= 768) break;
            const int qb = 7 - u / 96; int r = u % 96; const int c0 = qb * 4;
            r = (r < 64) ? r + 32 : r - 64;
            if (r < 32 && !p6_seen) {
                if (tid == 0) { unsigned sp = 0; while (__hip_atomic_load(ctl + 192, __ATOMIC_RELAXED, __HIP_MEMORY_SCOPE_AGENT) < (unsigned)G) { __builtin_amdgcn_s_sleep(2); if (++sp > (1u << 22)) break; }
                    __builtin_amdgcn_fence(__ATOMIC_ACQUIRE, "agent"); asm volatile("s_waitcnt vmcnt(0)" ::: "memory"); }
                __syncthreads(); p6_seen = true; }
            if (r < 32) { const int b = r >> 3, h = r & 7; const size_t rb = (size_t)b * SEQ, rq = rb + (size_t)qb * 256;
                att::attn_unit<true, bf16, NUQ, NUKV, NUKV, DM>(QM + rq * NUQ + h * 192, KVM + rb * NUKV + h * 256, KPE + rb * 64, KVM + rb * NUKV + h * 256 + 128,
                                                               OC + rq * DM + h * 128, c0, qb * 256, cs64, (char*)lds);
            } else { r -= 32; const int b = r >> 4, h = (r >> 2) & 3, c = (r >> 1) & 1, vh = r & 1; const size_t rb = (size_t)b * SEQ, rq = rb + (size_t)qb * 256;
                att::attn_unit<false, float, NIN, NIN, NIN, 1024>(P + rq * NIN + 1024 + h * 256 + c * 128, P + rb * NIN + 2048 + h * 256 + c * 128, nullptr, P + rb * NIN + 3072 + h * 256 + vh * 128,
                                                                 OD + (size_t)c * M * 1024 + rq * 1024 + h * 256 + vh * 128, c0, qb * 256, cs64, (char*)lds);
            }
        }
    }
    SEAM(7);
    if (IN(8)) {
        const float s1 = wave_sum(args.in[12][lane] * args.in[13][lane] + args.in[12][lane + 64] * args.in[13][lane + 64]);
        const float s2 = wave_sum(args.in[14][lane] * args.in[15][lane] + args.in[14][lane + 64] * args.in[15][lane + 64]);
        const float lam = expf(s1) - expf(s2) + 0.2f;
        const f32x4 g = *((const f32x4*)args.in[16] + lane);
        {
            f32x4 av[4][4], bv[4][4];
#pragma unroll
            for (int k = 0; k < 4; ++k) { const int m = gw + k * NGW;
#pragma unroll
                for (int h = 0; h < 4; ++h) { const int mc = m < M ? m : M - 1;
                    av[k][h] = *((const f32x4*)(OD + (size_t)mc * 1024 + h * 256) + lane); bv[k][h] = *((const f32x4*)(OD + (size_t)(M + mc) * 1024 + h * 256) + lane); } }
#pragma unroll
            for (int k = 0; k < 4; ++k) { const int m = gw + k * NGW;
                if (m < M) {
#pragma unroll
                for (int h = 0; h < 4; ++h) {
                    const f32x4 d = av[k][h] - lam * bv[k][h]; const float rstd = 0.8f / sqrtf(wave_sum(dot4(d)) * (1.0f / 256.0f) + EPS);
                    const f32x4 y = d * rstd * g; v2u w; w.x = pk2(y.x, y.y); w.y = pk2(y.z, y.w);
                    *((v2u*)(OC + (size_t)m * DM + 1024 + h * 256) + lane) = w; } } }
            for (int m = gw + 4 * NGW; m < M; m += NGW) {
#pragma unroll
                for (int h = 0; h < 4; ++h) {
                    const f32x4 a = *((const f32x4*)(OD + (size_t)m * 1024 + h * 256) + lane), b = *((const f32x4*)(OD + (size_t)(M + m) * 1024 + h * 256) + lane);
                    const f32x4 d = a - lam * b; const float rstd = 0.8f / sqrtf(wave_sum(dot4(d)) * (1.0f / 256.0f) + EPS);
                    const f32x4 y = d * rstd * g; v2u w; w.x = pk2(y.x, y.y); w.y = pk2(y.z, y.w);
                    *((v2u*)(OC + (size_t)m * DM + 1024 + h * 256) + lane) = w; } }
        }
    }
    SEAM(8);
    if (IN(9)) GEMM_FUSED(EpiResB, OC, Wout, DM, DM, H, H, DM, args.in[18], 1.0f, (float*)(ctl + CW_RSS + 8192), pg8::PanelRms{XSLOT(2), XCNT(2), 8, 1.0f / DM, EPS});
    SEAM(9);

    if (IN(11)) {
        constexpr int I_DN = (FF / 64) * (DM / 32);
#define DESC_P11(r_, d_) CVT_SET(d_, args.in[22], Wd2, FF, DM, 0, (const float*)nullptr, (r_))
        LAS float* scr = (LAS float*)(ldsl + wave * 16384);
        if (G == 256) {
            if (bx < GC1) GEMM_PHASE_G(GC1, EpiSwiGLUR, H, Wgu2, NGU, DM, ACT, FF, (const float*)(ctl + CW_RSS + 8192));
            else CVT_RUN((bx - GC1) * NWAVES + wave, (256 - GC1) * NWAVES, I_DN, DESC_P11);
        } else { GEMM_PHASE(EpiSwiGLUR, H, Wgu2, NGU, DM, ACT, FF, (const float*)(ctl + CW_RSS + 8192)); CVT_RUN(gw, NGW, I_DN, DESC_P11); }
    }
    SEAM(11);
    if (IN(12)) GEMM_FUSED(EpiResC, ACT, Wd2, DM, FF, H, out, DM, args.in[23], 0.5f, (float*)nullptr, pg8::PanelRms{XSLOT(4), XCNT(4), 8, 1.0f / DM, EPS});
#undef IN
#undef SEAM
}

extern "C" void kernel_launch(void* const* d_in, const int* in_sizes, int n_in, void* d_out, int out_size, void* d_ws, size_t ws_size, hipStream_t stream) {
    static int grid = 0;
    if (grid == 0) {
        if (n_in != 24 || in_sizes[0] != M * DM || out_size != M * DM || ws_size < WS_END2) {
            fprintf(stderr, "kernel_launch: unexpected shapes: n_in %d in0 %d out %d ws %zu (need %zu)\n", n_in, n_in > 0 ? in_sizes[0] : -1, out_size, ws_size, (size_t)WS_END2); grid = -1; return; }
        int dev = 0, cus = 0, per_cu = 0;
        if (hipGetDevice(&dev) != hipSuccess || hipDeviceGetAttribute(&cus, hipDeviceAttributeMultiprocessorCount, dev) != hipSuccess) { grid = -1; return; }
        if (hipFuncSetAttribute((const void*)mk_fwd, hipFuncAttributeMaxDynamicSharedMemorySize, LDS_BYTES) != hipSuccess) { fprintf(stderr, "kernel_launch: hipFuncSetAttribute failed\n"); grid = -1; return; }
        if (hipOccupancyMaxActiveBlocksPerMultiprocessor(&per_cu, (const void*)mk_fwd, NTHR, LDS_BYTES) != hipSuccess || per_cu < 1) { fprintf(stderr, "kernel_launch: occupancy query says %d\n", per_cu); per_cu = 1; }
        (void)hipGetLastError();
        grid = cus;
    }
    if (grid < 0) return;
    if (hipMemsetAsync((char*)d_ws + WS_CTL, 0, CTL_ZERO_BYTES, stream) != hipSuccess) { fprintf(stderr, "kernel_launch: hipMemsetAsync failed\n"); return; }
    Args a{};
    for (int i = 0; i < 24; ++i) a.in[i] = (const float*)d_in[i];
    a.out = (float*)d_out; a.ws = (unsigned char*)d_ws;
#if MK_N_LAUNCHES == 1
    a.ph_lo = 0; a.ph_hi = N_PHASES;
    void* kargs[] = {&a};
    const hipError_t le = hipLaunchCooperativeKernel((const void*)mk_fwd, dim3(grid), dim3(NTHR), kargs, LDS_BYTES, stream);
    if (le != hipSuccess) fprintf(stderr, "kernel_launch: cooperative launch failed: %s (grid %d)\n", hipGetErrorName(le), grid);
#else
    for (int li = 0; li < N_PHASES; ++li) {
        a.ph_lo = li; a.ph_hi = li + 1;
        hipLaunchKernelGGL(mk_fwd, dim3(grid), dim3(NTHR), LDS_BYTES, stream, a);
        const hipError_t le = hipPeekAtLastError();
        if (le != hipSuccess) { fprintf(stderr, "kernel_launch: launch %d failed: %s\n", li, hipGetErrorName(le)); break; }
    }
#endif
}
```

```cpp
#include <hip/hip_runtime.h>
#include <hip/hip_cooperative_groups.h>
#include <cstdio>
#include <cstdint>
namespace cg = cooperative_groups;
namespace pg8 {
#define PG8_LAS __attribute__((address_space(3)))
typedef unsigned short bf16_t;
typedef short bf16x8 __attribute__((ext_vector_type(8)));
typedef float f32x4 __attribute__((ext_vector_type(4)));
typedef unsigned u32x4 __attribute__((ext_vector_type(4)));
constexpr int BM = 256, BK = 64, HALF = 128, HTB = HALF * BK * 2  , STAGE_BYTES = 8 * HTB, NXCD = 8, WGM = 8;

__host__ __device__ __forceinline__ int lds_byte(int r, int c) { const int st = (r >> 4) * 2 + (c >> 5), rr = r & 15, cc = c & 31, ob = rr * 64 + cc * 2; return st * 1024 + (ob ^ (((ob >> 9) & 1) << 5)); }
__host__ __device__ __forceinline__ void stage_rc(int b, int& R, int& C) { const int st = b / 1024, sb = b % 1024, swz = sb ^ (((sb >> 9) & 1) << 5); R = (st >> 1) * 16 + swz / 64; C = (st & 1) * 32 + (swz % 64) / 2; }
__host__ __device__ __forceinline__ int perm32(int rho) { const int n = rho >> 4, i = rho & 15; return 8 * (i >> 2) + 4 * n + (i & 3); }

struct Unit { int pm, pn; };
struct Gemm { const bf16_t* A; const bf16_t* Bt; int M, N, K; int lda; };

struct StaticOrder {
    int nM, nN, nwg, G, c;
    __host__ __device__ __forceinline__ void init(int M, int N, int G_, int c_) { nM = M / BM; nN = N / BM; nwg = nM * nN; G = G_; c = c_; }
    __host__ __device__ __forceinline__ bool next(int i, Unit& u) const {
        const long L = (long)i * G + c; if (L >= nwg) return false;
        int wgid = (int)L; { const int q = nwg / NXCD, r = nwg % NXCD, xcd = wgid % NXCD, off = wgid / NXCD; wgid = (xcd < r ? xcd * (q + 1) : r * (q + 1) + (xcd - r) * q) + off; }
        const int nig = WGM * nN, gid = wgid / nig, fm = gid * WGM, gsz = (nM - fm) < WGM ? (nM - fm) : WGM;
        u.pm = fm + ((wgid % nig) % gsz); u.pn = (wgid % nig) / gsz; return true;
    }
    __device__ __forceinline__ void a_ready(const Unit&) const {}
    __device__ __forceinline__ void done(const Unit&) const {}
};

__device__ __forceinline__ unsigned cvt_pk_bf16(float lo, float hi) { unsigned r; asm volatile("v_cvt_pk_bf16_f32 %0, %1, %2" : "=v"(r) : "v"(lo), "v"(hi)); return r; }
template <bool RS> struct EpiBf16T {
    static constexpr bool PERM = true, AFTER_DRAIN = false;
    bf16_t* O; int ldc; const float* rowss; float* latss; const float* cs128; const float* cs64; bf16_t* KPE;
    template <bool R128> __device__ __forceinline__ void rope_tile(const f32x4 (&acc)[2][2][4][2], const Unit& u, int row0, int wc, int fq) const {
        const int ih = R128 ? 32 * (wc & 1) + 8 * fq : 8 * fq;
#pragma unroll
        for (int ai = 0; ai < 2; ++ai)
#pragma unroll
            for (int m = 0; m < 4; ++m) { const int row = row0 + ai * HALF + m * 16, pos = row & 2047;
                const float sc = 1.0f / sqrtf(rowss[row] * (1.0f / 2048.0f) + 1e-6f);
                const f32x4* cs; if constexpr (R128) cs = (const f32x4*)(cs128 + ((size_t)pos * 64 + ih) * 2); else cs = (const f32x4*)(cs64 + ((size_t)pos * 32 + ih) * 2);
                u32x4 w1, w2;
#pragma unroll
                for (int n = 0; n < 2; ++n) { const f32x4 x1 = acc[ai][0][m][n] * sc, x2 = acc[ai][1][m][n] * sc, c01 = cs[2 * n], c23 = cs[2 * n + 1];
                    const unsigned a0 = cvt_pk_bf16(x1[0] * c01[0] - x2[0] * c01[1], x1[1] * c01[2] - x2[1] * c01[3]), a1 = cvt_pk_bf16(x1[2] * c23[0] - x2[2] * c23[1], x1[3] * c23[2] - x2[3] * c23[3]);
                    const unsigned b0 = cvt_pk_bf16(x2[0] * c01[0] + x1[0] * c01[1], x2[1] * c01[2] + x1[1] * c01[3]), b1 = cvt_pk_bf16(x2[2] * c23[0] + x1[2] * c23[1], x2[3] * c23[2] + x1[3] * c23[3]);
                    if (n == 0) { w1.x = a0; w1.y = a1; w2.x = b0; w2.y = b1; } else { w1.z = a0; w1.w = a1; w2.z = b0; w2.w = b1; } }
                if constexpr (R128) { bf16_t* dst = O + (size_t)row * ldc + u.pn * BM + (wc >> 1) * 128 + ih; *(u32x4*)dst = w1; *(u32x4*)(dst + 64) = w2; }
                else { bf16_t* dst = KPE + (size_t)row * 64 + ih; *(u32x4*)dst = w1; *(u32x4*)(dst + 32) = w2; } }
    }
    __device__ __forceinline__ void operator()(const f32x4 (&acc)[2][2][4][2], const Unit& u, int wr, int wc, int fr, int fq) const {
        const int row0 = u.pm * BM + wr * 64 + fr; const int col0 = u.pn * BM + wc * 32 + 8 * fq;
        if constexpr (RS) {
            if (u.pn >= 4 && u.pn < 12) { rope_tile<true>(acc, u, row0, wc, fq); return; }
            if (u.pn == 16) { if (wc == 0) rope_tile<false>(acc, u, row0, wc, fq); return; }
        }
#pragma unroll
        for (int ai = 0; ai < 2; ++ai)
#pragma unroll
            for (int m = 0; m < 4; ++m) { bf16_t* rowp = O + (size_t)(row0 + ai * HALF + m * 16) * ldc + col0;
                float sc = 1.0f; if constexpr (RS) sc = 1.0f / sqrtf(rowss[row0 + ai * HALF + m * 16] * (1.0f / 2048.0f) + 1e-6f);
                float s2 = 0.f;
#pragma unroll
                for (int bj = 0; bj < 2; ++bj) { const f32x4 v0 = acc[ai][bj][m][0] * sc, v1 = acc[ai][bj][m][1] * sc;
                    u32x4 w; w.x = cvt_pk_bf16(v0[0], v0[1]); w.y = cvt_pk_bf16(v0[2], v0[3]); w.z = cvt_pk_bf16(v1[0], v1[1]); w.w = cvt_pk_bf16(v1[2], v1[3]);
                    *(u32x4*)(rowp + bj * HALF) = w;
                    if constexpr (RS) {
#pragma unroll
                        for (int k = 0; k < 4; ++k) { const float a = __uint_as_float(w[k] << 16), b = __uint_as_float(w[k] & 0xffff0000u); s2 += a * a + b * b; } } }
                if constexpr (RS) { if (u.pn < 4) { s2 += __shfl_xor(s2, 16); s2 += __shfl_xor(s2, 32);
                    if (fq == 0) (void)__hip_atomic_fetch_add(latss + (u.pn >> 1) * 8192 + row0 + ai * HALF + m * 16, s2, __ATOMIC_RELAXED, __HIP_MEMORY_SCOPE_AGENT); } } }
    }
};
typedef EpiBf16T<false> EpiBf16; typedef EpiBf16T<true> EpiBf16R;
struct EpiBf16Rs {
    static constexpr bool PERM = true, AFTER_DRAIN = false;
    bf16_t* O; int ldc; const PG8_LAS float* S;
    __device__ __forceinline__ void operator()(const f32x4 (&acc)[2][2][4][2], const Unit& u, int wr, int wc, int fr, int fq) const {
        const int row0 = u.pm * BM + wr * 64 + fr; const int col0 = u.pn * BM + wc * 32 + 8 * fq;
#pragma unroll
        for (int ai = 0; ai < 2; ++ai)
#pragma unroll
            for (int m = 0; m < 4; ++m) { bf16_t* rowp = O + (size_t)(row0 + ai * HALF + m * 16) * ldc + col0; const float sc = S[wr * 64 + fr + ai * HALF + m * 16];
#pragma unroll
                for (int bj = 0; bj < 2; ++bj) { const f32x4 v0 = acc[ai][bj][m][0] * sc, v1 = acc[ai][bj][m][1] * sc;
                    u32x4 w; w.x = cvt_pk_bf16(v0[0], v0[1]); w.y = cvt_pk_bf16(v0[2], v0[3]); w.z = cvt_pk_bf16(v1[0], v1[1]); w.w = cvt_pk_bf16(v1[2], v1[3]);
                    *(u32x4*)(rowp + bj * HALF) = w; } }
    }
};
__device__ __forceinline__ float silu_mul(float g, float u) { return g * u * __builtin_amdgcn_rcpf(1.0f + __builtin_amdgcn_exp2f(g * -1.4426950408889634f)); }
template <bool RS> struct EpiSwiGLUT {
    static constexpr bool PERM = true, AFTER_DRAIN = false;
    bf16_t* O; int ldc; const float* rowss;
    __device__ __forceinline__ void operator()(const f32x4 (&acc)[2][2][4][2], const Unit& u, int wr, int wc, int fr, int fq) const {
        const int row0 = u.pm * BM + wr * 64 + fr; const int col0 = u.pn * HALF + wc * 32 + 8 * fq;
#pragma unroll
        for (int ai = 0; ai < 2; ++ai)
#pragma unroll
            for (int m = 0; m < 4; ++m) { bf16_t* rowp = O + (size_t)(row0 + ai * HALF + m * 16) * ldc + col0;
                float sc = 1.0f; if constexpr (RS) sc = 1.0f / sqrtf(rowss[row0 + ai * HALF + m * 16] * (1.0f / 2048.0f) + 1e-6f);
                f32x4 g0 = acc[ai][0][m][0], g1 = acc[ai][0][m][1], u0 = acc[ai][1][m][0], u1 = acc[ai][1][m][1];
                if constexpr (RS) { g0 = g0 * sc; g1 = g1 * sc; u0 = u0 * sc; u1 = u1 * sc; }
                f32x4 e0 = g0 * -1.4426950408889634f, e1 = g1 * -1.4426950408889634f;
#pragma unroll
                for (int k = 0; k < 4; ++k) { e0[k] = __builtin_amdgcn_exp2f(e0[k]); e1[k] = __builtin_amdgcn_exp2f(e1[k]); }
                e0 = e0 + 1.0f; e1 = e1 + 1.0f;
#pragma unroll
                for (int k = 0; k < 4; ++k) { e0[k] = __builtin_amdgcn_rcpf(e0[k]); e1[k] = __builtin_amdgcn_rcpf(e1[k]); }
                const f32x4 o0 = (g0 * u0) * e0, o1 = (g1 * u1) * e1;
                u32x4 w; w.x = cvt_pk_bf16(o0[0], o0[1]); w.y = cvt_pk_bf16(o0[2], o0[3]); w.z = cvt_pk_bf16(o1[0], o1[1]); w.w = cvt_pk_bf16(o1[2], o1[3]);
                *(u32x4*)rowp = w; }
    }
};
typedef EpiSwiGLUT<false> EpiSwiGLU; typedef EpiSwiGLUT<true> EpiSwiGLUR;
struct EpiF32 {
    static constexpr bool PERM = false, AFTER_DRAIN = false;
    float* O; int ldc;
    __device__ __forceinline__ void operator()(const f32x4 (&acc)[2][2][4][2], const Unit& u, int wr, int wc, int fr, int fq) const {
        const int row0 = u.pm * BM + wr * 64 + fr; const int col0 = u.pn * BM + wc * 32 + 4 * fq;
#pragma unroll
        for (int ai = 0; ai < 2; ++ai)
#pragma unroll
            for (int m = 0; m < 4; ++m) { float* rowp = O + (size_t)(row0 + ai * HALF + m * 16) * ldc + col0;
#pragma unroll
                for (int bj = 0; bj < 2; ++bj)
#pragma unroll
                    for (int n = 0; n < 2; ++n) *(f32x4*)(rowp + bj * HALF + n * 16) = acc[ai][bj][m][n]; }
    }
};

struct PanelRms {
    float* xbuf;
    unsigned* cnt;
    int ntn; float inv_n, eps;
    __device__ __forceinline__ void publish(const f32x4 (&v)[2][2][4][2], const Unit& u, int wr, int wc, int fr, int fq, PG8_LAS unsigned char* lds, int wid, int lane) const {
        PG8_LAS float* P = (PG8_LAS float*)lds;
#pragma unroll
        for (int ai = 0; ai < 2; ++ai)
#pragma unroll
            for (int m = 0; m < 4; ++m) {
                float s = 0.f;
#pragma unroll
                for (int bj = 0; bj < 2; ++bj)
#pragma unroll
                    for (int n = 0; n < 2; ++n) { const f32x4 x = v[ai][bj][m][n]; s += (x[0] * x[0] + x[1] * x[1]) + (x[2] * x[2] + x[3] * x[3]); }
                s += __shfl_xor(s, 16); s += __shfl_xor(s, 32);
                if (fq == 0) P[(ai * HALF + wr * 64 + m * 16 + fr) * 4 + wc] = s;
            }
        asm volatile("s_waitcnt lgkmcnt(0)" ::: "memory"); __builtin_amdgcn_s_barrier(); asm volatile("" ::: "memory");
        const int row = wid * 32 + (lane & 31);
        if (lane < 32) {
            const float t = (P[row * 4 + 0] + P[row * 4 + 1]) + (P[row * 4 + 2] + P[row * 4 + 3]);
            __hip_atomic_store((unsigned*)xbuf + ((size_t)(u.pm * BM + row) * 8 + u.pn), __float_as_uint(t) | 1u, __ATOMIC_RELAXED, __HIP_MEMORY_SCOPE_AGENT);
        }
    }
    __device__ __forceinline__ void collect(const Unit& u, PG8_LAS unsigned char* lds, int wid, int lane) const {
        PG8_LAS float* S = (PG8_LAS float*)(lds + 4096);
        const int row = wid * 32 + (lane & 31);
        if (lane < 32) {
            const unsigned* slot = (const unsigned*)xbuf + (size_t)(u.pm * BM + row) * 8; unsigned w[8]; unsigned sp = 0;
            for (;;) { unsigned all = 1u;
#pragma unroll
                for (int k = 0; k < 8; ++k) { w[k] = (k < ntn) ? __hip_atomic_load(slot + k, __ATOMIC_RELAXED, __HIP_MEMORY_SCOPE_AGENT) : 1u; all &= w[k]; }
                if (all & 1u) break;
                __builtin_amdgcn_s_sleep(1); if (++sp > (1u << 20)) break; }
            float t = 0.f;
#pragma unroll
            for (int k = 0; k < 8; ++k) if (k < ntn) t += __uint_as_float(w[k]);
            S[row] = 1.0f / sqrtf(t * inv_n + eps);
        }
        asm volatile("s_waitcnt lgkmcnt(0)" ::: "memory"); __builtin_amdgcn_s_barrier(); asm volatile("" ::: "memory");
    }
};
typedef unsigned u32x2v __attribute__((ext_vector_type(2)));
__device__ __forceinline__ f32x4 raw_load4(const float* p) { return __builtin_nontemporal_load((const f32x4*)p); }
__device__ __forceinline__ u32x2v raw_load4(const bf16_t* p) { return *(const u32x2v*)p; }
__device__ __forceinline__ f32x4 raw_cvt4(f32x4 r) { return r; }
__device__ __forceinline__ f32x4 raw_cvt4(u32x2v r) { return (f32x4){__uint_as_float(r.x << 16), __uint_as_float(r.x & 0xffff0000u), __uint_as_float(r.y << 16), __uint_as_float(r.y & 0xffff0000u)}; }
template <typename TB, typename TO, bool STAT>
struct EpiRmsRes2 {
    static constexpr bool PERM = false, AFTER_DRAIN = true;
    const TB* base; TO* out; int ldc; const float* g; float coef; float* rowss; PanelRms st;
    __device__ __forceinline__ void fused(f32x4 (&acc)[2][2][4][2], const Unit& u, int wr, int wc, int fr, int fq, PG8_LAS unsigned char* lds, int wid, int lane) const {
        const PG8_LAS float* S = (const PG8_LAS float*)(lds + 4096);
        const int col0 = u.pn * BM + wc * 32 + 4 * fq;
        st.publish(acc, u, wr, wc, fr, fq, lds, wid, lane);
        decltype(raw_load4(base)) pre[4][2][2];
#pragma unroll
        for (int m = 0; m < 4; ++m) { const size_t off = (size_t)(u.pm * BM + wr * 64 + m * 16 + fr) * ldc + col0;
#pragma unroll
            for (int bj = 0; bj < 2; ++bj)
#pragma unroll
                for (int n = 0; n < 2; ++n) pre[m][bj][n] = raw_load4(base + off + bj * HALF + n * 16); }
        st.collect(u, lds, wid, lane);
        f32x4 gv[2][2];
#pragma unroll
        for (int bj = 0; bj < 2; ++bj)
#pragma unroll
            for (int n = 0; n < 2; ++n) gv[bj][n] = *(const f32x4*)(g + col0 + bj * HALF + n * 16) * coef;
#pragma unroll
        for (int ai = 0; ai < 2; ++ai)
#pragma unroll
            for (int m = 0; m < 4; ++m) { const int r = ai * HALF + wr * 64 + m * 16 + fr; const float rs = S[r]; const size_t off = (size_t)(u.pm * BM + r) * ldc + col0; float s2 = 0.f;
#pragma unroll
                for (int bj = 0; bj < 2; ++bj)
#pragma unroll
                    for (int n = 0; n < 2; ++n) { const f32x4 bs = raw_cvt4(ai == 0 ? pre[m][bj][n] : raw_load4(base + off + bj * HALF + n * 16));
                        const f32x4 y = bs + acc[ai][bj][m][n] * rs * gv[bj][n];
                        if constexpr (sizeof(TO) == 2) { u32x2v w; w.x = cvt_pk_bf16(y[0], y[1]); w.y = cvt_pk_bf16(y[2], y[3]); *(u32x2v*)(out + off + bj * HALF + n * 16) = w;
                            if constexpr (STAT) { const f32x4 yr = raw_cvt4(w); s2 += (yr[0] * yr[0] + yr[1] * yr[1]) + (yr[2] * yr[2] + yr[3] * yr[3]); } }
                        else { __builtin_nontemporal_store(y, (f32x4*)(out + off + bj * HALF + n * 16)); if constexpr (STAT) s2 += (y[0] * y[0] + y[1] * y[1]) + (y[2] * y[2] + y[3] * y[3]); } }
                if constexpr (STAT) { s2 += __shfl_xor(s2, 16); s2 += __shfl_xor(s2, 32);
                    if (fq == 0) (void)__hip_atomic_fetch_add(rowss + (u.pm * BM + r), s2, __ATOMIC_RELAXED, __HIP_MEMORY_SCOPE_AGENT); }
                if (m & 1) asm volatile("" ::: "memory"); }
    }
};
typedef EpiRmsRes2<float, bf16_t, true> EpiResA; typedef EpiRmsRes2<bf16_t, bf16_t, true> EpiResB; typedef EpiRmsRes2<bf16_t, float, false> EpiResC;

template <class Epi, class Sched, bool ALIGN_EPI = false, bool SP2 = false>
__device__ __forceinline__ void gemm_phase(PG8_LAS unsigned char* lds, const Gemm g, const Sched& S, const Epi& E) {
    int tid_ = threadIdx.x; asm volatile("" : "+v"(tid_));
    const int tid = tid_, wid = __builtin_amdgcn_readfirstlane(tid >> 6), lane = tid & 63, wr = wid >> 2, wc = wid & 3, fr = lane & 15, fq = lane >> 4;
    const int K = g.K, nt = K / BK, lda = g.lda ? g.lda : K;
    unsigned voffA[2], voffB[2];
#pragma unroll
    for (int i = 0; i < 2; ++i) { int R, C; stage_rc(tid * 16 + i * 8192, R, C); const int Rb = Epi::PERM ? ((R & ~31) + perm32(R & 31)) : R;
        voffA[i] = (unsigned)(R * lda + C) * 2u; voffB[i] = (unsigned)(Rb * K + C) * 2u; }
    const size_t kstep = (size_t)(BK * 2);
    const size_t hstep = (size_t)HALF * K * 2;
    const size_t hstepA = (size_t)HALF * lda * 2, tstepA = 2 * hstepA;
    const size_t tstep = 2 * hstep;
    const unsigned ldsw = (unsigned)wid * 1024u;
    const int aoff = lds_byte(wr * 64 + fr, fq * 8), boff = lds_byte(wc * 32 + fr, fq * 8);
#define PG8_SA(b, h) (((b) * 2 + (h)) * HTB)
#define PG8_SB(b, h) ((4 + (b) * 2 + (h)) * HTB)
#define PG8_STAGE(bufoff, gbase, voff) do { _Pragma("unroll") for (int _i = 0; _i < 2; ++_i) \
        __builtin_amdgcn_global_load_lds((const unsigned*)((const char*)(gbase) + (voff)[_i]), (PG8_LAS unsigned*)(lds + (bufoff) + ldsw + _i * 8192), 16, 0, 0); } while (0)
#define PG8_LDA(dst, b, h) do { _Pragma("unroll") for (int m = 0; m < 4; ++m) _Pragma("unroll") for (int k = 0; k < 2; ++k) dst[m][k] = *(const PG8_LAS bf16x8*)(lds + PG8_SA(b, h) + aoff + m * 2048 + k * 1024); } while (0)
#define PG8_LDB(dst, b, h) do { _Pragma("unroll") for (int n = 0; n < 2; ++n) _Pragma("unroll") for (int k = 0; k < 2; ++k) dst[n][k] = *(const PG8_LAS bf16x8*)(lds + PG8_SB(b, h) + boff + n * 2048 + k * 1024); } while (0)
#define PG8_MMA(ai, bj, At, Bt) do { __builtin_amdgcn_s_setprio(1); _Pragma("unroll") for (int m = 0; m < 4; ++m) _Pragma("unroll") for (int n = 0; n < 2; ++n) _Pragma("unroll") for (int k = 0; k < 2; ++k) \
        acc[ai][bj][m][n] = __builtin_amdgcn_mfma_f32_16x16x32_bf16(Bt[n][k], At[m][k], acc[ai][bj][m][n], 0, 0, 0); __builtin_amdgcn_s_setprio(0); } while (0)
#define PG8_WAIT_V(n) asm volatile("s_waitcnt vmcnt(" #n ")" ::: "memory")
#define PG8_WAIT_L(n) asm volatile("s_waitcnt lgkmcnt(" #n ")" ::: "memory")
#define PG8_BAR __builtin_amdgcn_s_barrier()
#define PG8_SCHED __builtin_amdgcn_sched_barrier(0)
    Unit cur, nxt; int ui = 0;
    if (!S.next(0, cur)) return;
    f32x4 acc[2][2][4][2];
#pragma unroll
    for (int a = 0; a < 2; ++a)
#pragma unroll
        for (int b = 0; b < 2; ++b)
#pragma unroll
            for (int m = 0; m < 4; ++m)
#pragma unroll
                for (int n = 0; n < 2; ++n) acc[a][b][m][n] = (f32x4){0.f, 0.f, 0.f, 0.f};
    bf16x8 At[4][2], B0[2][2], B1[2][2];
    const char* cA = (const char*)g.A + (size_t)cur.pm * tstepA; const char* cB = (const char*)g.Bt + (size_t)cur.pn * tstep;
    S.a_ready(cur);
    if constexpr (SP2) {
        PG8_STAGE(PG8_SB(0, 0), cB, voffB); PG8_STAGE(PG8_SB(0, 1), cB + hstep, voffB); PG8_STAGE(PG8_SA(0, 0), cA, voffA); PG8_STAGE(PG8_SA(0, 1), cA + hstepA, voffA);
        if (wr == 1) PG8_BAR;
        PG8_WAIT_V(2); PG8_BAR;
        PG8_STAGE(PG8_SB(1, 0), cB + kstep, voffB); PG8_STAGE(PG8_SA(1, 0), cA + kstep, voffA); PG8_STAGE(PG8_SB(1, 1), cB + hstep + kstep, voffB);
        PG8_WAIT_V(6); PG8_BAR;
    } else {
        PG8_STAGE(PG8_SB(0, 0), cB, voffB); PG8_STAGE(PG8_SA(0, 0), cA, voffA); PG8_STAGE(PG8_SB(0, 1), cB + hstep, voffB); PG8_STAGE(PG8_SA(0, 1), cA + hstepA, voffA);
        if (wr == 1) PG8_BAR;
        PG8_WAIT_V(4); PG8_BAR;
        PG8_STAGE(PG8_SB(1, 0), cB + kstep, voffB); PG8_STAGE(PG8_SA(1, 0), cA + kstep, voffA); PG8_STAGE(PG8_SB(1, 1), cB + hstep + kstep, voffB);
        PG8_WAIT_V(6); PG8_BAR;
    }
    for (;;) {
        const bool has_next = S.next(ui + 1, nxt);
        const char* nA = has_next ? (const char*)g.A + (size_t)nxt.pm * tstepA : cA; const char* nB = has_next ? (const char*)g.Bt + (size_t)nxt.pn * tstep : cB;
        for (int t = 0; t < nt; t += 2) {
            const bool last = (t == nt - 2);
            const char* a1 = cA + (size_t)(t + 1) * kstep;
            const char* a2 = last ? nA : cA + (size_t)(t + 2) * kstep; const char* b2 = last ? nB : cB + (size_t)(t + 2) * kstep;
            const char* a3 = a2 + kstep; const char* b3 = b2 + kstep;
            if (last && has_next) S.a_ready(nxt);
            if constexpr (SP2) {
            PG8_LDB(B0, 0, 0); PG8_LDB(B1, 0, 1); PG8_SCHED; PG8_LDA(At, 0, 0); PG8_STAGE(PG8_SA(1, 1), a1 + hstepA, voffA);
            PG8_WAIT_V(8); PG8_WAIT_L(0); PG8_BAR; PG8_MMA(0, 0, At, B0); PG8_MMA(0, 1, At, B1); PG8_BAR; PG8_SCHED;
            PG8_LDA(At, 0, 1); PG8_STAGE(PG8_SB(0, 0), b2, voffB); PG8_STAGE(PG8_SB(0, 1), b2 + hstep, voffB); PG8_STAGE(PG8_SA(0, 0), a2, voffA);
            PG8_WAIT_V(8); PG8_WAIT_L(0); PG8_BAR; PG8_MMA(1, 0, At, B0); PG8_MMA(1, 1, At, B1); PG8_BAR; PG8_SCHED;
            PG8_LDB(B0, 1, 0); PG8_LDB(B1, 1, 1); PG8_SCHED; PG8_LDA(At, 1, 0); PG8_STAGE(PG8_SA(0, 1), a2 + hstepA, voffA);
            PG8_WAIT_V(8); PG8_WAIT_L(0); PG8_BAR; PG8_MMA(0, 0, At, B0); PG8_MMA(0, 1, At, B1); PG8_BAR; PG8_SCHED;
            PG8_LDA(At, 1, 1); PG8_STAGE(PG8_SB(1, 0), b3, voffB); PG8_STAGE(PG8_SB(1, 1), b3 + hstep, voffB); PG8_STAGE(PG8_SA(1, 0), a3, voffA);
            PG8_WAIT_V(8); PG8_WAIT_L(0); PG8_BAR; PG8_MMA(1, 0, At, B0); PG8_MMA(1, 1, At, B1); PG8_BAR; PG8_SCHED;
            } else {
            PG8_LDB(B0, 0, 0); PG8_SCHED; PG8_LDA(At, 0, 0); PG8_STAGE(PG8_SA(1, 1), a1 + hstepA, voffA);
            PG8_WAIT_L(8); PG8_BAR; PG8_WAIT_L(0); PG8_MMA(0, 0, At, B0); PG8_BAR; PG8_SCHED;
            PG8_LDB(B1, 0, 1); PG8_STAGE(PG8_SB(0, 0), b2, voffB);
            PG8_BAR; PG8_WAIT_L(0); PG8_MMA(0, 1, At, B1); PG8_BAR;
            PG8_LDA(At, 0, 1); PG8_STAGE(PG8_SA(0, 0), a2, voffA);
            PG8_BAR; PG8_WAIT_L(0); PG8_MMA(1, 0, At, B0); PG8_BAR; PG8_SCHED;
            PG8_STAGE(PG8_SB(0, 1), b2 + hstep, voffB);
            PG8_WAIT_V(6); PG8_BAR; PG8_MMA(1, 1, At, B1); PG8_BAR;
            PG8_LDB(B0, 1, 0); PG8_SCHED; PG8_LDA(At, 1, 0); PG8_STAGE(PG8_SA(0, 1), a2 + hstepA, voffA);
            PG8_WAIT_L(8); PG8_BAR; PG8_WAIT_L(0); PG8_MMA(0, 0, At, B0); PG8_BAR; PG8_SCHED;
            PG8_LDB(B1, 1, 1); PG8_STAGE(PG8_SB(1, 0), b3, voffB);
            PG8_BAR; PG8_WAIT_L(0); PG8_MMA(0, 1, At, B1); PG8_BAR;
            PG8_LDA(At, 1, 1); PG8_STAGE(PG8_SA(1, 0), a3, voffA);
            PG8_BAR; PG8_WAIT_L(0); PG8_MMA(1, 0, At, B0); PG8_BAR; PG8_SCHED;
            PG8_STAGE(PG8_SB(1, 1), b3 + hstep, voffB);
            PG8_WAIT_V(6); PG8_BAR; PG8_MMA(1, 1, At, B1); PG8_BAR;
            }
        }
        if constexpr (ALIGN_EPI) { if (wr == 0) PG8_BAR; }
        if constexpr (!Epi::AFTER_DRAIN) { E(acc, cur, wr, wc, fr, fq); S.done(cur); }
        if (!has_next) break;
#pragma unroll
        for (int a = 0; a < 2; ++a)
#pragma unroll
            for (int b = 0; b < 2; ++b)
#pragma unroll
                for (int m = 0; m < 4; ++m)
#pragma unroll
                    for (int n = 0; n < 2; ++n) acc[a][b][m][n] = (f32x4){0.f, 0.f, 0.f, 0.f};
        cur = nxt; cA = nA; cB = nB; ++ui;
        if constexpr (ALIGN_EPI) { if (wr == 1) PG8_BAR; }
    }
    PG8_WAIT_V(0);
    if constexpr (!ALIGN_EPI) { if (wr == 0) PG8_BAR; }
    PG8_BAR;
    if constexpr (Epi::AFTER_DRAIN) { E.fused(acc, cur, wr, wc, fr, fq, lds, wid, lane); S.done(cur); }
#undef PG8_SA
#undef PG8_SB
#undef PG8_STAGE
#undef PG8_LDA
#undef PG8_LDB
#undef PG8_MMA
#undef PG8_WAIT_V
#undef PG8_WAIT_L
#undef PG8_BAR
#undef PG8_SCHED
}
}
namespace att {
typedef unsigned short bf16_t;
using bf16x8 = __attribute__((ext_vector_type(8))) short;
using s16x4  = __attribute__((ext_vector_type(4))) short;
using f32x16 = __attribute__((ext_vector_type(16))) float;
using f32x4  = __attribute__((ext_vector_type(4))) float;
using u32x4  = __attribute__((ext_vector_type(4))) unsigned;
constexpr int NW = 8, QBLK = 32, KVBLK = 64;
constexpr int SHM_V = KVBLK * 128 * 2, SHM_K = KVBLK * 128 * 2, SHM_KP = KVBLK * 64 * 2;
constexpr int OFF_V = 0, OFF_K = 2 * SHM_V, OFF_KP = OFF_K + 2 * SHM_K, OFF_WS = OFF_KP + 2 * SHM_KP, OFF_QP = OFF_WS + NW * 64 * 4, LDS_BYTES = OFF_QP + NW * 4096;
constexpr float THR = 8.f;
#define KSWZ(row, colB) ((row) * 256 + ((colB) ^ (((((row) & 7) | (((row) >> 1) & 8))) << 4)))
#define KPSWZ(row, colB) ((row) * 128 + ((colB) ^ ((((row) >> 1) & 7) << 4)))
#define SBAR() __builtin_amdgcn_sched_barrier(0)
__device__ __forceinline__ int crow(int r, int hi) { return (r & 3) + 8 * (r >> 2) + 4 * hi; }
__device__ __forceinline__ unsigned cvtpk(float lo, float hi) { unsigned r; asm volatile("v_cvt_pk_bf16_f32 %0, %1, %2" : "=v"(r) : "v"(lo), "v"(hi)); return r; }
__device__ __forceinline__ float bf2f(short s) { return __uint_as_float(((unsigned)(unsigned short)s) << 16); }

constexpr float THRL = THR * 1.4426950408889634f;
template <bool FIRST>
__device__ __forceinline__ void partialSM(f32x16& p0, f32x16& p1, float& m_reg, float& alpha) {
  float pmax = fmaxf(p0[0], p1[0]);
#pragma unroll
  for (int r = 1; r < 16; ++r) pmax = __builtin_fmaxf(__builtin_fmaxf(pmax, p0[r]), p1[r]);
  { auto rr = __builtin_amdgcn_permlane32_swap(__float_as_uint(pmax), __float_as_uint(pmax), false, false);
    pmax = fmaxf(__uint_as_float(rr[0]), __uint_as_float(rr[1])); }
  alpha = 1.f;
  if (FIRST || !__builtin_expect(__all(pmax <= THRL), 1)) {
    const float d = FIRST ? pmax : fmaxf(pmax, 0.f);
    m_reg += d; if (!FIRST) alpha = __builtin_amdgcn_exp2f(-d);
#pragma unroll
    for (int r = 0; r < 16; ++r) { p0[r] -= d; p1[r] -= d; }
  }
#pragma unroll
  for (int r = 0; r < 16; ++r) p0[r] = __builtin_amdgcn_exp2f(p0[r]);
}
__device__ __forceinline__ void finishSM(f32x16& p0, f32x16& p1, float alpha, float& l_reg, bf16x8& pa0, bf16x8& pa1, bf16x8& pa2, bf16x8& pa3) {
#pragma unroll
  for (int r = 0; r < 16; ++r) p1[r] = __builtin_amdgcn_exp2f(p1[r]);
  float ps = 0;
#pragma unroll
  for (int r = 0; r < 16; ++r) ps += p0[r];
#pragma unroll
  for (int r = 0; r < 16; ++r) ps += p1[r];
  { auto rr = __builtin_amdgcn_permlane32_swap(__float_as_uint(ps), __float_as_uint(ps), false, false);
    ps = __uint_as_float(rr[0]) + __uint_as_float(rr[1]); }
  l_reg = l_reg * alpha + ps;
#define PK4(P, BASE, OUT) do { unsigned a0 = cvtpk(P[BASE + 0], P[BASE + 1]), a1 = cvtpk(P[BASE + 2], P[BASE + 3]);   \
    unsigned b0 = cvtpk(P[BASE + 4], P[BASE + 5]), b1 = cvtpk(P[BASE + 6], P[BASE + 7]);                              \
    auto r0 = __builtin_amdgcn_permlane32_swap(a0, b0, false, false); auto r1 = __builtin_amdgcn_permlane32_swap(a1, b1, false, false); \
    u32x4 w = {r0[0], r1[0], r0[1], r1[1]}; OUT = *reinterpret_cast<bf16x8*>(&w); } while (0)
  PK4(p0, 0, pa0); PK4(p0, 8, pa1); PK4(p1, 0, pa2); PK4(p1, 8, pa3);
#undef PK4
}
template <bool MLA>
__device__ __forceinline__ void qkt(f32x16& p0, f32x16& p1, const char* Ks, const char* Kps, const char* Qps, const bf16x8* qr, int r32, int hi, float negm) {
#pragma unroll
  for (int r = 0; r < 16; ++r) { p0[r] = negm; p1[r] = negm; }
  asm volatile("" : "+v"(r32), "+v"(hi));
#pragma unroll
  for (int d0 = 0; d0 < 8; ++d0) { int cb = (d0 * 16 + hi * 8) * 2;
    bf16x8 b0 = *reinterpret_cast<const bf16x8*>(Ks + KSWZ(r32, cb));
    bf16x8 b1 = *reinterpret_cast<const bf16x8*>(Ks + KSWZ(32 + r32, cb));
    p0 = __builtin_amdgcn_mfma_f32_32x32x16_bf16(b0, qr[d0], p0, 0, 0, 0);
    p1 = __builtin_amdgcn_mfma_f32_32x32x16_bf16(b1, qr[d0], p1, 0, 0, 0); }
  if constexpr (MLA) {
    SBAR();
#pragma unroll
    for (int d0 = 0; d0 < 4; ++d0) { int cb = (d0 * 16 + hi * 8) * 2;
      bf16x8 b0 = *reinterpret_cast<const bf16x8*>(Kps + KPSWZ(r32, cb));
      bf16x8 b1 = *reinterpret_cast<const bf16x8*>(Kps + KPSWZ(32 + r32, cb));
      const bf16x8 qp = *reinterpret_cast<const bf16x8*>(Qps + KPSWZ(r32, cb));
      p0 = __builtin_amdgcn_mfma_f32_32x32x16_bf16(b0, qp, p0, 0, 0, 0);
      p1 = __builtin_amdgcn_mfma_f32_32x32x16_bf16(b1, qp, p1, 0, 0, 0); }
  }
}
__device__ __forceinline__ int v_st(int k, int c) { const int kk = (k & ~0xC) | ((k & 4) << 1) | ((k & 8) >> 1); return ((kk >> 3) * 4 + (c >> 5)) * 512 + ((kk & 7) * 32 + (c & 31)) * 2; }
__device__ __forceinline__ int v_rd_base(int lane) { return ((lane & 3) << 3) | (((lane >> 2) & 3) << 6) | (((lane >> 4) & 1) << 5) | (((lane >> 5) & 1) << 8); }
constexpr int v_rd_off(int d0, int ks, int half) { return d0 * 512 + ks * 4096 + half * 2048; }
template <int OFF> __device__ __forceinline__ s16x4 tr_read(int vb) {
  s16x4 r; asm volatile("ds_read_b64_tr_b16 %0, %1 offset:%2" : "=&v"(r) : "v"(vb), "i"(OFF) : "memory"); return r;
}
template <int D0> __device__ __forceinline__ void pv_one(f32x16& od, int vb, bf16x8 pa0, bf16x8 pa1, bf16x8 pa2, bf16x8 pa3) {
  const s16x4 l0 = tr_read<v_rd_off(D0, 0, 0)>(vb), h0 = tr_read<v_rd_off(D0, 0, 1)>(vb), l1 = tr_read<v_rd_off(D0, 1, 0)>(vb), h1 = tr_read<v_rd_off(D0, 1, 1)>(vb);
  const s16x4 l2 = tr_read<v_rd_off(D0, 2, 0)>(vb), h2 = tr_read<v_rd_off(D0, 2, 1)>(vb), l3 = tr_read<v_rd_off(D0, 3, 0)>(vb), h3 = tr_read<v_rd_off(D0, 3, 1)>(vb);
  asm volatile("s_waitcnt lgkmcnt(0)" ::: "memory"); SBAR();
#define PK(L, H) (bf16x8){L[0], L[1], L[2], L[3], H[0], H[1], H[2], H[3]}
  od = __builtin_amdgcn_mfma_f32_32x32x16_bf16(pa0, PK(l0, h0), od, 0, 0, 0);
  od = __builtin_amdgcn_mfma_f32_32x32x16_bf16(pa1, PK(l1, h1), od, 0, 0, 0);
  od = __builtin_amdgcn_mfma_f32_32x32x16_bf16(pa2, PK(l2, h2), od, 0, 0, 0);
  od = __builtin_amdgcn_mfma_f32_32x32x16_bf16(pa3, PK(l3, h3), od, 0, 0, 0);
#undef PK
}
__device__ __forceinline__ void pv_d0(f32x16* o, int vb, bf16x8 pa0, bf16x8 pa1, bf16x8 pa2, bf16x8 pa3) {
  pv_one<0>(o[0], vb, pa0, pa1, pa2, pa3); pv_one<1>(o[1], vb, pa0, pa1, pa2, pa3); pv_one<2>(o[2], vb, pa0, pa1, pa2, pa3); pv_one<3>(o[3], vb, pa0, pa1, pa2, pa3);
}
__device__ __forceinline__ void store_o(float* p, float v) { *p = v; }
__device__ __forceinline__ void store_o(bf16_t* p, float v) { unsigned u = __float_as_uint(v); *p = (bf16_t)((u + 0x7fffu + ((u >> 16) & 1u)) >> 16); }

template <bool MLA, typename TO, int LDQ, int LDK, int LDV, int LDO>
__device__ __forceinline__ void attn_unit(const bf16_t* __restrict__ Qb, const bf16_t* __restrict__ Kh, const bf16_t* __restrict__ Kpe, const bf16_t* __restrict__ Vh,
                                          TO* __restrict__ Ob, const int c0, const int pos0, const float* __restrict__ cs64, char* lds) {
  constexpr int NQ = 8;
  constexpr float SCALE = MLA ? 0.07216878364870322f : 0.08838834764831845f;
  constexpr float C = SCALE * 1.4426950408889634f, THRS = THR / SCALE;
  const int tid = threadIdx.x, wid = tid >> 6, lane = tid & 63, r32 = lane & 31, hi = lane >> 5;
  char* V_lds = lds + OFF_V; char* K_lds = lds + OFF_K; char* KP_lds = lds + OFF_KP; char* QP_lds = lds + OFF_QP + wid * 4096;
  float* ws = (float*)(lds + OFF_WS) + wid * 64; float* li_l = ws; float* al_l = ws + 32;
  float m_reg = 0.f, l_reg = 0; f32x16 o[4] = {}; bf16x8 qr[NQ];
  const int NT = c0 + 4, jmax = c0 + (wid >> 1);
  const bf16_t* Qw = Qb + (long)(wid * QBLK + r32) * LDQ + hi * 8;
#pragma unroll
  for (int d0 = 0; d0 < NQ; ++d0) qr[d0] = *reinterpret_cast<const bf16x8*>(Qw + d0 * 16);
  if constexpr (MLA) {
    const int pos = pos0 + wid * QBLK + r32;
#pragma unroll
    for (int a = 0; a < 2; ++a) {
      const f32x4* t = reinterpret_cast<const f32x4*>(cs64 + ((long)pos * 32 + 16 * a + 8 * hi) * 2);
      const bf16x8 x1 = *reinterpret_cast<const bf16x8*>(Qw + 128 + a * 16), x2 = *reinterpret_cast<const bf16x8*>(Qw + 128 + (a + 2) * 16); u32x4 w1, w2;
#pragma unroll
      for (int jj = 0; jj < 4; ++jj) { const f32x4 cs = t[jj];
        const float a0 = bf2f(x1[2 * jj]), a1 = bf2f(x1[2 * jj + 1]), b0 = bf2f(x2[2 * jj]), b1 = bf2f(x2[2 * jj + 1]);
        w1[jj] = cvtpk(a0 * cs[0] - b0 * cs[1], a1 * cs[2] - b1 * cs[3]);
        w2[jj] = cvtpk(b0 * cs[0] + a0 * cs[1], b1 * cs[2] + a1 * cs[3]); }
      *reinterpret_cast<u32x4*>(QP_lds + KPSWZ(r32, (a * 16 + hi * 8) * 2)) = w1; *reinterpret_cast<u32x4*>(QP_lds + KPSWZ(r32, ((a + 2) * 16 + hi * 8) * 2)) = w2;
    }
  }
  const int sr = tid >> 4, sc = (tid & 15) * 8, vst0 = v_st(sr, sc), vst1 = v_st(32 + sr, sc);
  const int kpr = tid >> 3, kpc = (tid & 7) * 8;
  const int vb0 = (int)(uintptr_t)V_lds + v_rd_base(lane);
  bf16x8 vs0, vs1, ks0, ks1, kp0;
#define SLOAD(k0) do { vs0 = *reinterpret_cast<const bf16x8*>(&Vh[(long)((k0) + sr) * LDV + sc]); vs1 = *reinterpret_cast<const bf16x8*>(&Vh[(long)((k0) + 32 + sr) * LDV + sc]); \
    ks0 = *reinterpret_cast<const bf16x8*>(&Kh[(long)((k0) + sr) * LDK + sc]); ks1 = *reinterpret_cast<const bf16x8*>(&Kh[(long)((k0) + 32 + sr) * LDK + sc]); \
    if constexpr (MLA) kp0 = *reinterpret_cast<const bf16x8*>(&Kpe[(long)((k0) + kpr) * 64 + kpc]); } while (0)
#define SWRITE(b) do { *(bf16x8*)(V_lds + (b) * SHM_V + vst0) = vs0; *(bf16x8*)(V_lds + (b) * SHM_V + vst1) = vs1; { int kc = sc * 2; \
    *(bf16x8*)(K_lds + (b) * SHM_K + KSWZ(sr, kc)) = ks0; *(bf16x8*)(K_lds + (b) * SHM_K + KSWZ(32 + sr, kc)) = ks1; } \
    if constexpr (MLA) *(bf16x8*)(KP_lds + (b) * SHM_KP + KPSWZ(kpr, kpc * 2)) = kp0; } while (0)
#define SWAIT() asm volatile("s_waitcnt vmcnt(0)" ::: "memory")
#define RESC(a) do { if (__any((a) < 1.f)) { if (hi == 0) al_l[r32] = (a); asm volatile("s_waitcnt lgkmcnt(0)" ::: "memory"); \
    _Pragma("unroll") for (int d = 0; d < 4; ++d) _Pragma("unroll") for (int r = 0; r < 16; ++r) o[d][r] *= al_l[crow(r, hi)]; } } while (0)
#define MASKF(P0, P1) do { _Pragma("unroll") for (int r = 0; r < 16; ++r) { P0[r] = -1e30f; P1[r] = -1e30f; } } while (0)
#define MASKT(P0, P1, j) do { if ((j) > jmax) { _Pragma("unroll") for (int r = 0; r < 16; ++r) { P0[r] = -1e30f; P1[r] = -1e30f; } } } while (0)
  f32x16 pA0, pA1, pB0, pB1; float mnA, mnB, alA, alB; bf16x8 pa0, pa1, pa2, pa3;
  SLOAD(0); SWAIT(); SWRITE(0); __syncthreads();
  qkt<MLA>(pA0, pA1, K_lds, KP_lds, QP_lds, qr, r32, hi, 0.f); partialSM<true>(pA0, pA1, m_reg, alA);
  SLOAD(KVBLK);
  SWAIT(); SWRITE(1); __syncthreads();
  for (int j = 1; j + 1 < NT; j += 2) {
    SBAR(); if (j <= jmax) qkt<MLA>(pB0, pB1, K_lds + SHM_K, KP_lds + SHM_KP, QP_lds, qr, r32, hi, -m_reg); else MASKF(pB0, pB1);
    finishSM(pA0, pA1, alA, l_reg, pa0, pa1, pa2, pa3); SBAR();
    SLOAD((j + 1) * KVBLK); SBAR();
    pv_d0(o, vb0, pa0, pa1, pa2, pa3); partialSM<false>(pB0, pB1, m_reg, alB);
    __syncthreads(); SWAIT(); SWRITE(0);
    RESC(alB); __syncthreads();
    SBAR(); if (j + 1 <= jmax) qkt<MLA>(pA0, pA1, K_lds, KP_lds, QP_lds, qr, r32, hi, -m_reg); else MASKF(pA0, pA1);
    finishSM(pB0, pB1, alB, l_reg, pa0, pa1, pa2, pa3); SBAR();
    SLOAD((j + 2) * KVBLK); SBAR();
    pv_d0(o, vb0 + SHM_V, pa0, pa1, pa2, pa3); partialSM<false>(pA0, pA1, m_reg, alA);
    __syncthreads(); SWAIT(); SWRITE(1);
    RESC(alA); __syncthreads();
  }
  SBAR(); if (NT - 1 <= jmax) qkt<MLA>(pB0, pB1, K_lds + SHM_K, KP_lds + SHM_KP, QP_lds, qr, r32, hi, -m_reg); else MASKF(pB0, pB1);
  finishSM(pA0, pA1, alA, l_reg, pa0, pa1, pa2, pa3); SBAR();
  pv_d0(o, vb0, pa0, pa1, pa2, pa3); partialSM<false>(pB0, pB1, m_reg, alB);
  __syncthreads(); RESC(alB);
  finishSM(pB0, pB1, alB, l_reg, pa0, pa1, pa2, pa3); SBAR();
  pv_d0(o, vb0 + SHM_V, pa0, pa1, pa2, pa3);
  if (hi == 0) li_l[r32] = l_reg; asm volatile("s_waitcnt lgkmcnt(0)" ::: "memory");
  float rli[16];
#pragma unroll
  for (int r = 0; r < 16; ++r) rli[r] = __builtin_amdgcn_rcpf(li_l[crow(r, hi)]);
  TO* Ow = Ob + (long)(wid * QBLK) * LDO;
#pragma unroll
  for (int r = 0; r < 16; ++r) { const int orow = crow(r, hi);
#pragma unroll
    for (int d0 = 0; d0 < 4; ++d0) store_o(Ow + (long)orow * LDO + d0 * 32 + r32, o[d0][r] * rli[r]); }
  __syncthreads();
#undef SLOAD
#undef SWRITE
#undef SWAIT
#undef RESC
#undef MASKT
#undef MASKF
}
#undef SBAR
}
#ifndef MK_N_LAUNCHES
#define MK_N_LAUNCHES 1
#endif
constexpr int N_PHASES = 14;
constexpr int NWAVES = 8, NTHR = NWAVES * 64;
constexpr int M = 8192, DM = 2048, FF = 5632, SEQ = 2048, NIN = 4352, NGU = 2 * FF;
constexpr int QRANK = 512, NUQ = 1536, NUKV = 2048;
constexpr float EPS = 1e-6f;
typedef unsigned short bf16;
typedef float f32x4 __attribute__((ext_vector_type(4)));
typedef short bf16x8 __attribute__((ext_vector_type(8)));
typedef unsigned v4u __attribute__((ext_vector_type(4)));
typedef unsigned v2u __attribute__((ext_vector_type(2)));
#define LAS __attribute__((address_space(3)))
#define LDS_WAIT() asm volatile("s_waitcnt lgkmcnt(0)" ::: "memory")

constexpr size_t MiB = 1u << 20;
constexpr size_t WS_CTL = 0, WS_CS64 = 1 * MiB, WS_CS128 = 1 * MiB + 512 * 1024;
constexpr size_t WS_WGU1 = 3 * MiB, WS_WD1 = 47 * MiB, WS_WIN = 69 * MiB, WS_WUQ = 86 * MiB, WS_WUKV = 88 * MiB, WS_WOUT = 90 * MiB, WS_WGU2 = 98 * MiB, WS_WD2 = 142 * MiB;
constexpr size_t WS_H = 164 * MiB, WS_ACT = 196 * MiB, WS_F = 284 * MiB, WS_END = 348 * MiB;
constexpr size_t WS_XCH = 348 * MiB, WS_OC2 = 350 * MiB, WS_END2 = 382 * MiB;
constexpr size_t WS_OC = WS_OC2;
constexpr size_t WS_P = 196 * MiB, WS_QM = 264 * MiB, WS_KVM = 288 * MiB, WS_KPE = 320 * MiB, WS_CQN = 321 * MiB, WS_CKVN = 329 * MiB;
constexpr size_t WS_OD = 3 * MiB;
static_assert(WS_WGU1 + (size_t)NGU * DM * 2 <= WS_WD1 && WS_WD1 + (size_t)DM * FF * 2 <= WS_WIN && WS_WIN + (size_t)NIN * DM * 2 <= WS_WUQ && WS_WUQ + (size_t)NUQ * QRANK * 2 <= WS_WUKV &&
              WS_WUKV + (size_t)NUKV * QRANK * 2 <= WS_WOUT && WS_WOUT + (size_t)DM * DM * 2 <= WS_WGU2 && WS_WGU2 + (size_t)NGU * DM * 2 <= WS_WD2 && WS_WD2 + (size_t)DM * FF * 2 <= WS_H, "weights map");
static_assert(WS_H + (size_t)M * DM * 2 <= WS_ACT && WS_ACT + (size_t)M * FF * 2 <= WS_F && WS_F + (size_t)M * DM * 4 <= WS_END, "activation map");
static_assert(WS_P + (size_t)M * NIN * 2 <= WS_QM && WS_QM + (size_t)M * NUQ * 2 <= WS_KVM && WS_KVM + (size_t)M * NUKV * 2 <= WS_KPE && WS_KPE + (size_t)M * 64 * 2 <= WS_CQN &&
              WS_CQN + (size_t)M * QRANK * 2 <= WS_CKVN && WS_CKVN + (size_t)M * QRANK * 2 <= WS_END && WS_OD + (size_t)2 * M * 1024 * 4 <= WS_WIN, "mixer map");

constexpr int RING_BYTES = 131072, MISC_OFF = RING_BYTES, LDS_BYTES = 147456;
static_assert(att::LDS_BYTES <= RING_BYTES, "attention scratch fits the ring");

__device__ __forceinline__ unsigned f2bf(float f) { unsigned u = __builtin_bit_cast(unsigned, f); return (u + 0x7fffu + ((u >> 16) & 1u)) >> 16; }
__device__ __forceinline__ unsigned pk2(float lo, float hi) { return f2bf(lo) | (f2bf(hi) << 16); }
__device__ __forceinline__ float bf2f(short s) { return __uint_as_float(((unsigned)(unsigned short)s) << 16); }
__device__ __forceinline__ float wave_sum(float v) {
#pragma unroll
    for (int o = 1; o < 64; o <<= 1) v += __shfl_xor(v, o);
    return v;
}
__device__ __forceinline__ float dot4(f32x4 a) { return (a.x * a.x + a.y * a.y) + (a.z * a.z + a.w * a.w); }

template <bool SCALE = false>
__device__ __forceinline__ void transpose_item(const float* W, int K, int N, bf16* WT, int orow0, LAS float* scr, int k0, int n0, int lane, const float* gk = nullptr) {
#pragma unroll 8
    for (int i = 0; i < 32; ++i) { const int kk = 2 * i + (lane >> 5); float w = W[(size_t)(k0 + kk) * N + n0 + (lane & 31)]; if constexpr (SCALE) w *= gk[k0 + kk]; scr[kk * 33 + (lane & 31)] = w; }
    LDS_WAIT(); asm volatile("" ::: "memory");
    const int c = lane & 7;
#pragma unroll
    for (int j = 0; j < 4; ++j) { const int n = (lane >> 3) + 8 * j; const LAS float* s = scr + (8 * c) * 33 + n;
        v4u o; o.x = pk2(s[0 * 33], s[1 * 33]); o.y = pk2(s[2 * 33], s[3 * 33]); o.z = pk2(s[4 * 33], s[5 * 33]); o.w = pk2(s[6 * 33], s[7 * 33]);
        *(v4u*)(WT + (size_t)(orow0 + n) * K + k0 + 8 * c) = o; }
    LDS_WAIT(); asm volatile("" ::: "memory");
}
__device__ __forceinline__ int map_row(int map, int n0) {
    if (map == 0 || map == 4) return n0;
    if (map == 1) return (n0 >> 7) * 256 + (n0 & 127);
    if (map == 2) return (n0 >> 7) * 256 + 128 + (n0 & 127);
    if (n0 < 1024) return n0;
    if (n0 < 1088) return n0 == 1024 ? 4096 : 4096 + 128;
    if (n0 >= 3136) return n0 - 64;
    const int rel = n0 - 1088, h = (rel >> 8) & 3, w = rel & 255, c = w >> 7, e = w & 127;
    return 1024 + (rel >> 10) * 1024 + h * 256 + (e < 64 ? c * 64 + e : 128 + c * 64 + (e - 64));
}
template <bool SCALE = false>
__device__ __forceinline__ void transpose_mat(const float* W, int K, int N, bf16* WT, int map, LAS float* scr, int item, int lane, const float* gk = nullptr) {
    const int nblk = N / 32, kb = item / nblk, nb = item - kb * nblk;
    transpose_item<SCALE>(W, K, N, WT, map_row(map, nb * 32), scr, kb * 64, nb * 32, lane, gk);
}
struct CvtDesc { const float* W; bf16* WT; const float* gk; int K, N, map, item; };
__device__ __forceinline__ void cvt_load(const CvtDesc& d, int lane, float (&v)[32], f32x4& g0, f32x4& g1) {
    const int nblk = d.N >> 5, kb = d.item / nblk, nb = d.item - kb * nblk, k0 = kb * 64, n0 = nb * 32;
    const float* src = d.W + (size_t)(k0 + (lane >> 5)) * d.N + n0 + (lane & 31); const size_t step = (size_t)2 * d.N;
#pragma unroll
    for (int i = 0; i < 32; ++i) v[i] = __builtin_nontemporal_load(src + i * step);
    if (d.gk) { const float* gp = d.gk + k0 + 8 * (lane & 7); g0 = *(const f32x4*)gp; g1 = *(const f32x4*)(gp + 4); } else { g0 = (f32x4){1.f, 1.f, 1.f, 1.f}; g1 = g0; }
}
__device__ __forceinline__ void cvt_finish(const CvtDesc& d, int lane, const float (&v)[32], f32x4 g0, f32x4 g1, LAS float* scr) {
    const int nblk = d.N >> 5, kb = d.item / nblk, nb = d.item - kb * nblk, k0 = kb * 64, n0 = nb * 32, orow0 = map_row(d.map, n0);
    const float os = d.map == 4 ? 0.07216878364870322f * 1.4426950408889634f : (d.map == 3 && n0 >= 1088 && n0 < 2112) ? 0.08838834764831845f * 1.4426950408889634f : 1.0f;
    g0 = g0 * os; g1 = g1 * os;
#pragma unroll
    for (int i = 0; i < 32; ++i) scr[(2 * i + (lane >> 5)) * 33 + (lane & 31)] = v[i];
    LDS_WAIT(); asm volatile("" ::: "memory");
    const int c = lane & 7;
#pragma unroll
    for (int j = 0; j < 4; ++j) { const int n = (lane >> 3) + 8 * j; const LAS float* q = scr + (8 * c) * 33 + n;
        v4u o; o.x = pk2(q[0 * 33] * g0.x, q[1 * 33] * g0.y); o.y = pk2(q[2 * 33] * g0.z, q[3 * 33] * g0.w); o.z = pk2(q[4 * 33] * g1.x, q[5 * 33] * g1.y); o.w = pk2(q[6 * 33] * g1.z, q[7 * 33] * g1.w);
        *(v4u*)(d.WT + (size_t)(orow0 + n) * d.K + k0 + 8 * c) = o; }
    LDS_WAIT(); asm volatile("" ::: "memory");
}
#define CVT_SET(d, W_, WT_, K_, N_, map_, gk_, item_) do { (d).W = (W_); (d).WT = (WT_); (d).K = (K_); (d).N = (N_); (d).map = (map_); (d).gk = (gk_); (d).item = (item_); } while (0)
#define CVT_RUN(first, stride, total, DESC) do { int it_ = (first); CvtDesc da_, db_; float va_[32], vb_[32]; f32x4 ga0_, ga1_, gb0_ = {0.f, 0.f, 0.f, 0.f}, gb1_ = gb0_; \
        _Pragma("unroll") for (int i_ = 0; i_ < 32; ++i_) vb_[i_] = 0.f; \
        bool have_ = it_ < (total); if (have_) { DESC(it_, da_); db_ = da_; cvt_load(da_, lane, va_, ga0_, ga1_); } \
        while (have_) { const int it2_ = it_ + (stride); const bool have2_ = it2_ < (total); \
            if (have2_) { DESC(it2_, db_); cvt_load(db_, lane, vb_, gb0_, gb1_); } \
            cvt_finish(da_, lane, va_, ga0_, ga1_, scr); \
            da_ = db_; _Pragma("unroll") for (int i_ = 0; i_ < 32; ++i_) va_[i_] = vb_[i_]; ga0_ = gb0_; ga1_ = gb1_; it_ = it2_; have_ = have2_; } } while (0)

__device__ __forceinline__ void sincos_acc(float angf, float& c, float& s) {
    const double x = (double)angf; const double n = __builtin_rint(x * 0.15915494309189535);
    double r = __builtin_fma(-n, 6.283185307179586, x); r = __builtin_fma(-n, 2.4492935982947064e-16, r);
    const double r2 = r * r; double ts = 1.0, tc = 1.0, ss = 1.0, cc = 1.0;
#pragma unroll
    for (int k = 1; k <= 15; ++k) { tc *= -r2 * (1.0 / (double)((2 * k - 1) * (2 * k))); cc += tc; ts *= -r2 * (1.0 / (double)((2 * k) * (2 * k + 1))); ss += ts; }
    s = (float)(r * ss); c = (float)cc;
}
__device__ __forceinline__ float inv_freq_acc(int i2, int d) {
    const double y = -(double)i2 * (d == 64 ? 1.0 / 64.0 : 1.0 / 128.0) * 9.210340371976184; const double z = y * 0.0625; double t = 1.0, e = 1.0;
#pragma unroll
    for (int k = 1; k <= 16; ++k) { t *= z * (1.0 / (double)k); e += t; }
    e *= e; e *= e; e *= e; e *= e; return (float)e;
}

#define RLX_AGENT __ATOMIC_RELAXED, __HIP_MEMORY_SCOPE_AGENT
#define XB_TMO      128
#define XB_XCNT(j)  (256  + 64 * (j))
#define XB_XSUB(j)  (1280 + 64 * (j))
#define XB_XGEN(j)  (2304 + 64 * (j))
#define XB_TOP      3328
#define XB_TOPGEN   3392
#define XCD_BAR_WORDS 3456
#define XB_SPIN_CAP (1u << 18)

__device__ __forceinline__ unsigned xb_ld(unsigned* p)              { return __hip_atomic_load(p, __ATOMIC_RELAXED, __HIP_MEMORY_SCOPE_AGENT); }
__device__ __forceinline__ unsigned xb_add(unsigned* p, unsigned v) { return __hip_atomic_fetch_add(p, v, __ATOMIC_RELAXED, __HIP_MEMORY_SCOPE_AGENT); }
__device__ __forceinline__ unsigned xb_xcc_id() { return (unsigned)__builtin_amdgcn_s_getreg((3 << 11) | 20) & 0xFu; }
#define XB_SPIN(cond, bar) do { unsigned _sp = 0; while (cond) { __builtin_amdgcn_s_sleep(1); \
    if ((++_sp & 255u) == 0u) { if (xb_ld(&(bar)[XB_TMO])) break; if (_sp > XB_SPIN_CAP) { atomicAdd(&(bar)[XB_TMO], 1u); break; } } } } while (0)

struct XcdBarrier {
    unsigned* bar; unsigned x;
    volatile LAS unsigned* st;
};

__device__ __forceinline__ XcdBarrier xcd_barrier_post(unsigned* bar, volatile LAS unsigned* st) {
    XcdBarrier b; b.bar = bar; b.x = xb_xcc_id(); b.st = st;
    if (threadIdx.x == 0) (void)xb_add(&bar[XB_XCNT(b.x)], 1u);
    return b;
}
__device__ __forceinline__ void xcd_barrier_complete(unsigned* bar, unsigned x, unsigned& nloc, unsigned& nx) {
    const unsigned G = gridDim.x * gridDim.y * gridDim.z;
    unsigned sum, cnt, mine, sp = 0u;
    for (;;) {
        sum = 0u; cnt = 0u; mine = 0u;
#pragma unroll
        for (unsigned j = 0; j < 16; ++j) { const unsigned c = xb_ld(&bar[XB_XCNT(j)]); sum += c; cnt += (c > 0u) ? 1u : 0u; mine = (j == x) ? c : mine; }
        if (sum == G) break;
        __builtin_amdgcn_s_sleep(1);
        if ((++sp & 255u) == 0u) { if (xb_ld(&bar[XB_TMO])) break; if (sp > XB_SPIN_CAP) { atomicAdd(&bar[XB_TMO], 1u); break; } }
    }
    nloc = mine > 0u ? mine : 1u; nx = cnt > 0u ? cnt : 1u;
}

__device__ __forceinline__ void xcd_barrier(const XcdBarrier& b) {
    asm volatile("s_waitcnt vmcnt(0)" ::: "memory");
    __syncthreads();
    if (threadIdx.x == 0) {
        unsigned* bar = b.bar;
        __builtin_amdgcn_s_waitcnt(0);
        unsigned nloc = b.st[0], nx = b.st[1];
        if (nloc == 0u) { xcd_barrier_complete(bar, b.x, nloc, nx); b.st[0] = nloc; b.st[1] = nx; }
        const unsigned old = xb_add(&bar[XB_XSUB(b.x)], 1u);
        const unsigned gen = old / nloc;
        if (old + 1u == (gen + 1u) * nloc) {
            __builtin_amdgcn_fence(__ATOMIC_RELEASE, "agent");
            asm volatile("s_waitcnt vmcnt(0)" ::: "memory");
            const unsigned og = xb_add(&bar[XB_TOP], 1u);
            const unsigned tg = og / nx;
            if (og + 1u == (tg + 1u) * nx) xb_add(&bar[XB_TOPGEN], 1u);
            else XB_SPIN(xb_ld(&bar[XB_TOPGEN]) == tg, bar);
            __builtin_amdgcn_fence(__ATOMIC_ACQUIRE, "agent");
            xb_add(&bar[XB_XGEN(b.x)], 1u);
            asm volatile("s_waitcnt vmcnt(0)" ::: "memory");
        } else {
            XB_SPIN(xb_ld(&bar[XB_XGEN(b.x)]) == gen, bar);
            __builtin_amdgcn_fence(__ATOMIC_ACQUIRE, "agent");
            asm volatile("s_waitcnt vmcnt(0)" ::: "memory");
        }
    }
    __syncthreads();
}

constexpr int CW_BAR = 4096;
constexpr size_t CTL_ZERO_BYTES = 262144;
constexpr int CW_RSS = 32768;
constexpr int CW_CNT = 8192;
struct Args { const float* in[24]; float* out; unsigned char* ws; int ph_lo, ph_hi; };

__global__ void __launch_bounds__(NTHR, 2) mk_fwd(Args args) {
    __builtin_assume(__builtin_amdgcn_workitem_id_y() == 0); __builtin_assume(__builtin_amdgcn_workitem_id_z() == 0);
    extern __shared__ __attribute__((aligned(16))) unsigned char lds[];
    cg::grid_group grid = cg::this_grid();
    LAS unsigned char* ldsl = (LAS unsigned char*)lds;
    const int tid = threadIdx.x, lane = tid & 63, wave = __builtin_amdgcn_readfirstlane(tid >> 6);
    const int G = gridDim.x, bx = blockIdx.x;
    const int vcu = (G % 8 == 0) ? (bx % 8) * (G / 8) + bx / 8 : bx;
    const int gw = vcu * NWAVES + wave, NGW = G * NWAVES;
    unsigned char* ws = args.ws;
    const float* x = args.in[0]; float* out = args.out;
    unsigned* ctl = (unsigned*)(ws + WS_CTL);
    float* cs64 = (float*)(ws + WS_CS64); float* cs128 = (float*)(ws + WS_CS128);
    bf16* Wgu1 = (bf16*)(ws + WS_WGU1); bf16* Wd1 = (bf16*)(ws + WS_WD1); bf16* Win = (bf16*)(ws + WS_WIN); bf16* Wuq = (bf16*)(ws + WS_WUQ); bf16* Wukv = (bf16*)(ws + WS_WUKV);
    bf16* Wout = (bf16*)(ws + WS_WOUT); bf16* Wgu2 = (bf16*)(ws + WS_WGU2); bf16* Wd2 = (bf16*)(ws + WS_WD2);
    bf16* H = (bf16*)(ws + WS_H); bf16* ACT = (bf16*)(ws + WS_ACT); float* F = (float*)(ws + WS_F); bf16* OC = (bf16*)(ws + WS_OC);
    bf16* P = (bf16*)(ws + WS_P); bf16* QM = (bf16*)(ws + WS_QM); bf16* KVM = (bf16*)(ws + WS_KVM); bf16* KPE = (bf16*)(ws + WS_KPE); bf16* CQN = (bf16*)(ws + WS_CQN); bf16* CKVN = (bf16*)(ws + WS_CKVN);
    float* OD = (float*)(ws + WS_OD);
    const int lo = args.ph_lo, hi = args.ph_hi;
    volatile LAS unsigned* MISC = (volatile LAS unsigned*)(ldsl + MISC_OFF);
    if (tid < 32) MISC[tid] = 0u;
    __syncthreads();
    const XcdBarrier bar = xcd_barrier_post(ctl + CW_BAR, MISC + 8);
    if (lo > 1000) grid.sync();
#ifndef PH_MASK
#define PH_MASK 0x3fff
#endif
#define IN(k) ((((PH_MASK) >> (k)) & 1) && lo <= (k) && (k) < hi)
#ifndef PROBE_DUP
#define PROBE_DUP -1
#endif
#define REP(k) for (int rep_ = 0; rep_ < ((k) == PROBE_DUP ? 2 : 1); ++rep_)
#define SEAM(k) do { if (IN(k) && IN((k) + 1)) xcd_barrier(bar); } while (0)

    if (IN(0)) REP(0) {
        if (bx == 0 && tid == 0) __hip_atomic_store(ctl, 0u, __ATOMIC_RELAXED, __HIP_MEMORY_SCOPE_AGENT);
        LAS float* scr = (LAS float*)(ldsl + wave * 16384);
        constexpr int I_GU = (DM / 64) * (FF / 32), I_DN = (FF / 64) * (DM / 32);
        constexpr int NITEMS = 2 * I_GU;
#define DESC_P0(r_, d_) do { if ((r_) < I_GU) CVT_SET(d_, args.in[2], Wgu1, DM, FF, 1, (const float*)nullptr, (r_)); else CVT_SET(d_, args.in[3], Wgu1, DM, FF, 2, (const float*)nullptr, (r_) - I_GU); } while (0)
        CVT_RUN(gw, NGW, NITEMS, DESC_P0);
        { const int gt0 = vcu * NTHR + tid, NGT0 = G * NTHR; v4u z0 = {0u, 0u, 0u, 0u};
          for (int i = gt0; i < 5 * M * 8 / 4; i += NGT0) *((v4u*)(ws + WS_XCH) + i) = z0; }
        {
            const int gt = vcu * NTHR + tid, NGT = G * NTHR; v4u z = {0u, 0u, 0u, 0u};
            for (int i = gt; i < 192 * DM / 8; i += NGT) { const int half = i / (96 * DM / 8), j = i - half * (96 * DM / 8); *((v4u*)(Win + (size_t)(half ? 4256 : 4128) * DM) + j) = z; }
            for (int e = gt; e < SEQ * 32; e += NGT) { const int pos = e >> 5, i = e & 31; float c, s; sincos_acc((float)pos * inv_freq_acc(2 * i, 64), c, s); cs64[2 * e] = c; cs64[2 * e + 1] = s; }
            for (int e = gt; e < SEQ * 64; e += NGT) { const int pos = e >> 6, i = e & 63; float c, s; sincos_acc((float)pos * inv_freq_acc(2 * i, 128), c, s); cs128[2 * e] = c; cs128[2 * e + 1] = s; }
        }
        const f32x4* g4 = (const f32x4*)args.in[1] + lane;
        for (int m = gw; m < M; m += NGW) {
            const f32x4* xr = (const f32x4*)(x + (size_t)m * DM) + lane; f32x4 v[8]; float ss = 0.f;
#pragma unroll
            for (int j = 0; j < 8; ++j) { v[j] = xr[64 * j]; ss += dot4(v[j]); }
            const float rstd = 1.0f / sqrtf(wave_sum(ss) * (1.0f / DM) + EPS);
            v2u* o8 = (v2u*)(H + (size_t)m * DM) + lane;
#pragma unroll
            for (int j = 0; j < 8; ++j) { const f32x4 g = g4[64 * j]; const f32x4 y = v[j] * rstd * g; v2u w; w.x = pk2(y.x, y.y); w.y = pk2(y.z, y.w); o8[64 * j] = w; }
        }
    }
    SEAM(0);
#define GEMM_PHASE(EPI, Aptr, Bptr, N_, K_, ...) GEMM_PHASE_G(G, EPI, Aptr, Bptr, N_, K_, __VA_ARGS__)
#define GEMM_PHASE_G(GE, EPI, Aptr, Bptr, N_, K_, ...) do { pg8::Gemm g{Aptr, Bptr, M, N_, K_}; pg8::StaticOrder S; S.init(M, N_, (GE), bx); pg8::EPI E{__VA_ARGS__}; \
        pg8::gemm_phase<pg8::EPI, pg8::StaticOrder, true, true>(ldsl, g, S, E); } while (0)
#define NORM_PHASE(base, gpost, coef, gnext) do { \
        const f32x4* gp4 = (const f32x4*)(gpost) + lane; const f32x4* gn4 = (const f32x4*)(gnext) + lane; \
        for (int m = gw; m < M; m += NGW) { \
            const f32x4* fr = (const f32x4*)(F + (size_t)m * DM) + lane; const f32x4* br = (const f32x4*)((base) + (size_t)m * DM) + lane; f32x4 v[8]; float ss = 0.f; \
            _Pragma("unroll") for (int j = 0; j < 8; ++j) { v[j] = fr[64 * j]; ss += dot4(v[j]); } \
            const float rstd = (coef) / sqrtf(wave_sum(ss) * (1.0f / DM) + EPS); float s2 = 0.f; \
            f32x4* xo = (f32x4*)(out + (size_t)m * DM) + lane; \
            _Pragma("unroll") for (int j = 0; j < 8; ++j) { v[j] = br[64 * j] + v[j] * rstd * gp4[64 * j]; s2 += dot4(v[j]); xo[64 * j] = v[j]; } \
            if ((gnext) != nullptr) { const float r2 = 1.0f / sqrtf(wave_sum(s2) * (1.0f / DM) + EPS); v2u* o8 = (v2u*)(H + (size_t)m * DM) + lane; \
                _Pragma("unroll") for (int j = 0; j < 8; ++j) { const f32x4 y = v[j] * r2 * gn4[64 * j]; v2u w; w.x = pk2(y.x, y.y); w.y = pk2(y.z, y.w); o8[64 * j] = w; } } \
        } } while (0)

    constexpr int GC1 = 235, GC4 = 182;
    if (IN(1)) {
        constexpr int I_DN = (FF / 64) * (DM / 32), I_IN = (DM / 64) * (4160 / 32), I_UQ = (QRANK / 64) * (NUQ / 32), I_UKV = (QRANK / 64) * (NUKV / 32), I_OUT = (DM / 64) * (DM / 32);
#define DESC_P1(r_, d_) do { if ((r_) < I_DN) CVT_SET(d_, args.in[4], Wd1, FF, DM, 0, (const float*)nullptr, (r_)); else if ((r_) < I_DN + I_IN) CVT_SET(d_, args.in[7], Win, DM, 4160, 3, args.in[6], (r_) - I_DN); \
            else if ((r_) < I_DN + I_IN + I_UQ) CVT_SET(d_, args.in[9], Wuq, QRANK, NUQ, 4, args.in[8], (r_) - I_DN - I_IN); \
            else if ((r_) < I_DN + I_IN + I_UQ + I_UKV) CVT_SET(d_, args.in[11], Wukv, QRANK, NUKV, 0, args.in[10], (r_) - I_DN - I_IN - I_UQ); else CVT_SET(d_, args.in[17], Wout, DM, DM, 0, (const float*)nullptr, (r_) - I_DN - I_IN - I_UQ - I_UKV); } while (0)
        LAS float* scr = (LAS float*)(ldsl + wave * 16384);
        if (G == 256) {
            if (bx < GC1) GEMM_PHASE_G(GC1, EpiSwiGLU, H, Wgu1, NGU, DM, ACT, FF, nullptr);
            else CVT_RUN((bx - GC1) * NWAVES + wave, (256 - GC1) * NWAVES, I_DN + I_IN + I_UQ + I_UKV + I_OUT, DESC_P1);
        } else { GEMM_PHASE(EpiSwiGLU, H, Wgu1, NGU, DM, ACT, FF, nullptr); CVT_RUN(gw, NGW, I_DN + I_IN + I_UQ + I_UKV + I_OUT, DESC_P1); }
    }
    SEAM(1);
#define XSLOT(b) ((float*)(ws + WS_XCH) + (size_t)(b) * M * 8)
#define XCNT(b) (ctl + CW_CNT + (b) * 2048)
#define GEMM_FUSED(EPI, Aptr, Bptr, N_, K_, ...) do { pg8::Gemm g{Aptr, Bptr, M, N_, K_}; pg8::StaticOrder S; S.init(M, N_, G, bx); pg8::EPI E{__VA_ARGS__}; \
        pg8::gemm_phase<pg8::EPI, pg8::StaticOrder, false, true>(ldsl, g, S, E); } while (0)
    if (IN(2)) REP(2) GEMM_FUSED(EpiResA, ACT, Wd1, DM, FF, x, H, DM, args.in[5], 0.5f, (float*)(ctl + CW_RSS), pg8::PanelRms{XSLOT(0), XCNT(0), 8, 1.0f / DM, EPS});
    SEAM(2);

    if (IN(4)) {
        constexpr int I_GU = (DM / 64) * (FF / 32);
#define DESC_P4(r_, d_) do { if ((r_) < I_GU) CVT_SET(d_, args.in[20], Wgu2, DM, FF, 1, args.in[19], (r_)); else CVT_SET(d_, args.in[21], Wgu2, DM, FF, 2, args.in[19], (r_) - I_GU); } while (0)
        LAS float* scr = (LAS float*)(ldsl + wave * 16384);
        if (G == 256) {
            if (bx < GC4) GEMM_PHASE_G(GC4, EpiBf16R, H, Win, NIN, DM, P, NIN, (const float*)(ctl + CW_RSS), (float*)(ctl + CW_RSS + 16384), cs128, cs64, KPE);
            else CVT_RUN((bx - GC4) * NWAVES + wave, (256 - GC4) * NWAVES, 2 * I_GU, DESC_P4);
        } else { GEMM_PHASE(EpiBf16R, H, Win, NIN, DM, P, NIN, (const float*)(ctl + CW_RSS), (float*)(ctl + CW_RSS + 16384), cs128, cs64, KPE); CVT_RUN(gw, NGW, 2 * I_GU, DESC_P4); }
    }
    SEAM(4);
    if (IN(6)) REP(6) {
        LAS float* SROW = (LAS float*)(ldsl + MISC_OFF + 256);
#pragma unroll 1
        for (int which = 0; which < 2; ++which) {
            const int N_ = which == 0 ? NUKV : NUQ; const bf16* Ap = P + (which == 0 ? 512 : 0);
            pg8::StaticOrder S; S.init(M, N_, G, bx); pg8::Unit u;
            if (S.next(0, u)) {
                if (lane < 32) { const float v = ((const float*)(ctl + CW_RSS + 16384))[(which == 0 ? 8192 : 0) + u.pm * 256 + wave * 32 + lane]; SROW[wave * 32 + lane] = 1.0f / sqrtf(v * (1.0f / QRANK) + EPS); }
            }
            __syncthreads();
            { pg8::Gemm g{Ap, which == 0 ? Wukv : Wuq, M, N_, QRANK, NIN}; pg8::EpiBf16Rs E{which == 0 ? KVM : QM, N_, SROW};
              pg8::gemm_phase<pg8::EpiBf16Rs, pg8::StaticOrder, true, true>(ldsl, g, S, E); }
            __syncthreads();
        }
        asm volatile("s_waitcnt vmcnt(0)" ::: "memory");
        __syncthreads();
        if (tid == 0) { __builtin_amdgcn_fence(__ATOMIC_RELEASE, "agent"); asm volatile("s_waitcnt vmcnt(0)" ::: "memory");
            (void)__hip_atomic_fetch_add(ctl + 192, 1u, __ATOMIC_RELAXED, __HIP_MEMORY_SCOPE_AGENT); }
    }
    if (IN(7)) {
        volatile LAS unsigned* misc = (volatile LAS unsigned*)(ldsl + MISC_OFF); bool p6_seen = !(IN(6));
        for (;;) {
            if (tid == 0) misc[0] = __hip_atomic_fetch_add(ctl, 1u, __ATOMIC_RELAXED, __HIP_MEMORY_SCOPE_AGENT);
            __syncthreads();
            const int u = (int)misc[0];
            __syncthreads();
            if (u >= 768) break;
            const int qb = 7 - u / 96; int r = u % 96; const int c0 = qb * 4;
            r = (r < 64) ? r + 32 : r - 64;
            if (r < 32 && !p6_seen) {
                if (tid == 0) { unsigned sp = 0; while (__hip_atomic_load(ctl + 192, __ATOMIC_RELAXED, __HIP_MEMORY_SCOPE_AGENT) < (unsigned)G) { __builtin_amdgcn_s_sleep(2); if (++sp > (1u << 22)) break; }
                    __builtin_amdgcn_fence(__ATOMIC_ACQUIRE, "agent"); asm volatile("s_waitcnt vmcnt(0)" ::: "memory"); }
                __syncthreads(); p6_seen = true; }
            if (r < 32) { const int b = r >> 3, h = r & 7; const size_t rb = (size_t)b * SEQ, rq = rb + (size_t)qb * 256;
                att::attn_unit<true, bf16, NUQ, NUKV, NUKV, DM>(QM + rq * NUQ + h * 192, KVM + rb * NUKV + h * 256, KPE + rb * 64, KVM + rb * NUKV + h * 256 + 128,
                                                               OC + rq * DM + h * 128, c0, qb * 256, cs64, (char*)lds);
            } else { r -= 32; const int b = r >> 4, h = (r >> 2) & 3, c = (r >> 1) & 1, vh = r & 1; const size_t rb = (size_t)b * SEQ, rq = rb + (size_t)qb * 256;
                att::attn_unit<false, float, NIN, NIN, NIN, 1024>(P + rq * NIN + 1024 + h * 256 + c * 128, P + rb * NIN + 2048 + h * 256 + c * 128, nullptr, P + rb * NIN + 3072 + h * 256 + vh * 128,
                                                                 OD + (size_t)c * M * 1024 + rq * 1024 + h * 256 + vh * 128, c0, qb * 256, cs64, (char*)lds);
            }
        }
    }
    SEAM(7);
    if (IN(8)) {
        const float s1 = wave_sum(args.in[12][lane] * args.in[13][lane] + args.in[12][lane + 64] * args.in[13][lane + 64]);
        const float s2 = wave_sum(args.in[14][lane] * args.in[15][lane] + args.in[14][lane + 64] * args.in[15][lane + 64]);
        const float lam = expf(s1) - expf(s2) + 0.2f;
        const f32x4 g = *((const f32x4*)args.in[16] + lane);
        {
            f32x4 av[4][4], bv[4][4];
#pragma unroll
            for (int k = 0; k < 4; ++k) { const int m = gw + k * NGW;
#pragma unroll
                for (int h = 0; h < 4; ++h) { const int mc = m < M ? m : M - 1;
                    av[k][h] = __builtin_nontemporal_load((const f32x4*)(OD + (size_t)mc * 1024 + h * 256) + lane); bv[k][h] = __builtin_nontemporal_load((const f32x4*)(OD + (size_t)(M + mc) * 1024 + h * 256) + lane); } }
#pragma unroll
            for (int k = 0; k < 4; ++k) { const int m = gw + k * NGW;
                if (m < M) {
#pragma unroll
                for (int h = 0; h < 4; ++h) {
                    const f32x4 d = av[k][h] - lam * bv[k][h]; const float rstd = 0.8f / sqrtf(wave_sum(dot4(d)) * (1.0f / 256.0f) + EPS);
                    const f32x4 y = d * rstd * g; v2u w; w.x = pk2(y.x, y.y); w.y = pk2(y.z, y.w);
                    *((v2u*)(OC + (size_t)m * DM + 1024 + h * 256) + lane) = w; } } }
            for (int m = gw + 4 * NGW; m < M; m += NGW) {
#pragma unroll
                for (int h = 0; h < 4; ++h) {
                    const f32x4 a = *((const f32x4*)(OD + (size_t)m * 1024 + h * 256) + lane), b = *((const f32x4*)(OD + (size_t)(M + m) * 1024 + h * 256) + lane);
                    const f32x4 d = a - lam * b; const float rstd = 0.8f / sqrtf(wave_sum(dot4(d)) * (1.0f / 256.0f) + EPS);
                    const f32x4 y = d * rstd * g; v2u w; w.x = pk2(y.x, y.y); w.y = pk2(y.z, y.w);
                    *((v2u*)(OC + (size_t)m * DM + 1024 + h * 256) + lane) = w; } }
        }
    }
    SEAM(8);
    if (IN(9)) GEMM_FUSED(EpiResB, OC, Wout, DM, DM, H, H, DM, args.in[18], 1.0f, (float*)(ctl + CW_RSS + 8192), pg8::PanelRms{XSLOT(2), XCNT(2), 8, 1.0f / DM, EPS});
    SEAM(9);

    if (IN(11)) {
        constexpr int I_DN = (FF / 64) * (DM / 32);
#define DESC_P11(r_, d_) CVT_SET(d_, args.in[22], Wd2, FF, DM, 0, (const float*)nullptr, (r_))
        LAS float* scr = (LAS float*)(ldsl + wave * 16384);
        if (G == 256) {
            if (bx < GC1) GEMM_PHASE_G(GC1, EpiSwiGLUR, H, Wgu2, NGU, DM, ACT, FF, (const float*)(ctl + CW_RSS + 8192));
            else CVT_RUN((bx - GC1) * NWAVES + wave, (256 - GC1) * NWAVES, I_DN, DESC_P11);
        } else { GEMM_PHASE(EpiSwiGLUR, H, Wgu2, NGU, DM, ACT, FF, (const float*)(ctl + CW_RSS + 8192)); CVT_RUN(gw, NGW, I_DN, DESC_P11); }
    }
    SEAM(11);
    if (IN(12)) GEMM_FUSED(EpiResC, ACT, Wd2, DM, FF, H, out, DM, args.in[23], 0.5f, (float*)nullptr, pg8::PanelRms{XSLOT(4), XCNT(4), 8, 1.0f / DM, EPS});
#undef IN
#undef SEAM
}

extern "C" void kernel_launch(void* const* d_in, const int* in_sizes, int n_in, void* d_out, int out_size, void* d_ws, size_t ws_size, hipStream_t stream) {
    static int grid = 0;
    if (grid == 0) {
        if (n_in != 24 || in_sizes[0] != M * DM || out_size != M * DM || ws_size < WS_END2) {
            fprintf(stderr, "kernel_launch: unexpected shapes: n_in %d in0 %d out %d ws %zu (need %zu)\n", n_in, n_in > 0 ? in_sizes[0] : -1, out_size, ws_size, (size_t)WS_END2); grid = -1; return; }
        int dev = 0, cus = 0, per_cu = 0;
        if (hipGetDevice(&dev) != hipSuccess || hipDeviceGetAttribute(&cus, hipDeviceAttributeMultiprocessorCount, dev) != hipSuccess) { grid = -1; return; }
        if (hipFuncSetAttribute((const void*)mk_fwd, hipFuncAttributeMaxDynamicSharedMemorySize, LDS_BYTES) != hipSuccess) { fprintf(stderr, "kernel_launch: hipFuncSetAttribute failed\n"); grid = -1; return; }
        if (hipOccupancyMaxActiveBlocksPerMultiprocessor(&per_cu, (const void*)mk_fwd, NTHR, LDS_BYTES) != hipSuccess || per_cu < 1) { fprintf(stderr, "kernel_launch: occupancy query says %d\n", per_cu); per_cu = 1; }
        (void)hipGetLastError();
        grid = cus;
    }
    if (grid < 0) return;
    if (hipMemsetAsync((char*)d_ws + WS_CTL, 0, CTL_ZERO_BYTES, stream) != hipSuccess) { fprintf(stderr, "kernel_launch: hipMemsetAsync failed\n"); return; }
    Args a{};
    for (int i = 0; i < 24; ++i) a.in[i] = (const float*)d_in[i];
    a.out = (float*)d_out; a.ws = (unsigned char*)d_ws;
#if MK_N_LAUNCHES == 1
    a.ph_lo = 0; a.ph_hi = N_PHASES;
    void* kargs[] = {&a};
    const hipError_t le = hipLaunchCooperativeKernel((const void*)mk_fwd, dim3(grid), dim3(NTHR), kargs, LDS_BYTES, stream);
    if (le != hipSuccess) fprintf(stderr, "kernel_launch: cooperative launch failed: %s (grid %d)\n", hipGetErrorName(le), grid);
#else
    for (int li = 0; li < N_PHASES; ++li) {
        a.ph_lo = li; a.ph_hi = li + 1;
        hipLaunchKernelGGL(mk_fwd, dim3(grid), dim3(NTHR), LDS_BYTES, stream, a);
        const hipError_t le = hipPeekAtLastError();
        if (le != hipSuccess) { fprintf(stderr, "kernel_launch: launch %d failed: %s\n", li, hipGetErrorName(le)); break; }
    }
#endif
}
```
